# Optimizing an MI355X kernel written in HIP

```python
import math
import jax, jax.numpy as jnp
from jax import lax
import numpy as np

D_MODEL = 1024
BATCH = 4
SEQ = 8192
DEPTH = 1

MLA_HEADS = 8
MLA_Q_LORA = 256
MLA_KV_LORA = 128
MLA_NOPE = 64
MLA_ROPE = 32
MLA_V = 64
SWA_HEADS = 8
SWA_KV_HEADS = 2
SWA_HEAD_DIM = 64
WINDOW = 128
BLOCK = 128
REL_BUCKETS = 32
REL_MAX_DIST = 128
ROPE_THETA = 10000.0
EPS = 1e-6

MLA_WIDTH = MLA_HEADS * MLA_V
SWA_WIDTH = SWA_HEADS * SWA_HEAD_DIM
MIX_WIDTH = MLA_WIDTH + SWA_WIDTH
IN_SPLITS = (MLA_Q_LORA, MLA_KV_LORA, MLA_ROPE,
             SWA_HEADS * SWA_HEAD_DIM, SWA_KV_HEADS * SWA_HEAD_DIM, SWA_KV_HEADS * SWA_HEAD_DIM,
             MIX_WIDTH)
IN_WIDTH = sum(IN_SPLITS)

kernel_name = "hymba_mla_swa_sink_gated"


def _offsets(sizes):
    out, acc = [], 0
    for s in sizes[:-1]:
        acc += s
        out.append(acc)
    return tuple(out)


def rmsnorm(x, g):
    xf = x.astype(jnp.float32)
    y = xf * lax.rsqrt(jnp.mean(xf * xf, axis=-1, keepdims=True) + EPS)
    return (y * g.astype(jnp.float32)).astype(x.dtype)


def rope(x, pos):
    half = x.shape[-1] // 2
    inv = ROPE_THETA ** (-jnp.arange(half, dtype=jnp.float32) / half)
    ang = pos.astype(jnp.float32)[..., None] * inv
    ang = ang.reshape(ang.shape[:2] + (1,) * (x.ndim - 3) + (half,))
    cos, sin = jnp.cos(ang), jnp.sin(ang)
    xf = x.astype(jnp.float32)
    x1, x2 = xf[..., :half], xf[..., half:]
    return jnp.concatenate([x1 * cos - x2 * sin, x2 * cos + x1 * sin], axis=-1).astype(x.dtype)


def t5_bucket(dist):
    n = jnp.maximum(dist, 0)
    max_exact = REL_BUCKETS // 2
    nf = jnp.maximum(n, 1).astype(jnp.float32)
    large = max_exact + (jnp.log(nf / max_exact) / math.log(REL_MAX_DIST / max_exact)
                         * (REL_BUCKETS - max_exact)).astype(jnp.int32)
    large = jnp.minimum(large, REL_BUCKETS - 1)
    return jnp.where(n < max_exact, n, large)


def mla_group(q_lat, kv_lat, k_rope, positions, q_a_norm, w_q_b, kv_a_norm, w_kv_b):
    B, S, _ = q_lat.shape
    q = (rmsnorm(q_lat, q_a_norm) @ w_q_b).reshape(B, S, MLA_HEADS, MLA_NOPE + MLA_ROPE)
    q_nope, q_pe = q[..., :MLA_NOPE], rope(q[..., MLA_NOPE:], positions)
    kv = (rmsnorm(kv_lat, kv_a_norm) @ w_kv_b).reshape(B, S, MLA_HEADS, MLA_NOPE + MLA_V)
    k_nope, v = kv[..., :MLA_NOPE], kv[..., MLA_NOPE:]
    k_pe = rope(k_rope, positions)
    scale = (MLA_NOPE + MLA_ROPE) ** -0.5
    nb = S // BLOCK
    qn_blocks = jnp.moveaxis(q_nope.reshape(B, nb, BLOCK, MLA_HEADS, MLA_NOPE), 1, 0)
    qp_blocks = jnp.moveaxis(q_pe.reshape(B, nb, BLOCK, MLA_HEADS, MLA_ROPE), 1, 0)
    key_idx = jnp.arange(S)

    def block_attn(args):
        i, qn, qp = args
        s = (jnp.einsum('bqhd,bkhd->bhqk', qn, k_nope)
             + jnp.einsum('bqhr,bkr->bhqk', qp, k_pe)).astype(jnp.float32) * scale
        q_idx = i * BLOCK + jnp.arange(BLOCK)
        mask = key_idx[None, :] <= q_idx[:, None]
        s = jnp.where(mask[None, None], s, -jnp.inf)
        p = jax.nn.softmax(s, axis=-1).astype(v.dtype)
        return jnp.einsum('bhqk,bkhd->bqhd', p, v)

    o = lax.map(block_attn, (jnp.arange(nb), qn_blocks, qp_blocks))
    return jnp.moveaxis(o, 0, 1).reshape(B, S, MLA_WIDTH)


def _band(t, nb):
    pad = [(0, 0), (BLOCK, 0)] + [(0, 0)] * (t.ndim - 2)
    tp = jnp.pad(t, pad).reshape((t.shape[0], nb + 1, BLOCK) + t.shape[2:])
    return jnp.concatenate([tp[:, :-1], tp[:, 1:]], axis=2)


def swa_group(q, k, v, positions, rel_bias, sinks):
    B, S, _ = q.shape
    G = SWA_HEADS // SWA_KV_HEADS
    nb = S // BLOCK
    qb = q.reshape(B, nb, BLOCK, SWA_KV_HEADS, G, SWA_HEAD_DIM)
    kb = _band(k.reshape(B, S, SWA_KV_HEADS, SWA_HEAD_DIM), nb)
    vb = _band(v.reshape(B, S, SWA_KV_HEADS, SWA_HEAD_DIM), nb)
    kpos = _band(positions, nb)
    qpos = positions.reshape(B, nb, BLOCK)
    qi = jnp.arange(BLOCK)[:, None] + BLOCK
    ki = jnp.arange(2 * BLOCK)[None, :]
    delta = qi - ki
    blk = jnp.arange(nb)[:, None, None]
    valid = (delta >= 0) & (delta < WINDOW) & (blk * BLOCK + ki[None] - BLOCK >= 0)
    bucket = t5_bucket(qpos[..., :, None] - kpos[..., None, :])
    bias = jnp.take(rel_bias, bucket, axis=0)
    bias = jnp.moveaxis(bias, -1, 2).reshape(B, nb, SWA_KV_HEADS, G, BLOCK, 2 * BLOCK)
    s = jnp.einsum('bnqhgd,bnkhd->bnhgqk', qb, kb).astype(jnp.float32) * (SWA_HEAD_DIM ** -0.5)
    s = s + bias.astype(jnp.float32)
    s = jnp.where(valid[None, :, None, None], s, -jnp.inf)
    sink = sinks.astype(jnp.float32).reshape(1, 1, SWA_KV_HEADS, G, 1, 1)
    m = jnp.maximum(jnp.max(s, axis=-1, keepdims=True), sink)
    e = jnp.exp(s - m)
    p = e / (jnp.sum(e, axis=-1, keepdims=True) + jnp.exp(sink - m))
    o = jnp.einsum('bnhgqk,bnkhd->bnqhgd', p.astype(vb.dtype), vb)
    return o.reshape(B, S, SWA_WIDTH)


def setup_inputs(seed: int = 0) -> dict:
    key = jax.random.key(seed)
    ks = jax.random.split(key, 16)
    f32 = jnp.float32
    x = jax.random.normal(ks[0], (BATCH, SEQ, D_MODEL), f32)
    offset = jax.random.randint(ks[1], (BATCH, 1), 0, 1024, dtype=jnp.int32)
    positions = (offset + jnp.arange(SEQ, dtype=jnp.int32)[None, :]).astype(jnp.int32)
    norm_gain = 1.0 + 0.05 * jax.random.normal(ks[2], (DEPTH, D_MODEL), f32)
    w_in = jax.random.normal(ks[3], (DEPTH, D_MODEL, IN_WIDTH), f32) * D_MODEL ** -0.5
    q_a_norm = 1.0 + 0.05 * jax.random.normal(ks[4], (DEPTH, MLA_Q_LORA), f32)
    w_q_b = jax.random.normal(ks[5], (DEPTH, MLA_Q_LORA, MLA_HEADS * (MLA_NOPE + MLA_ROPE)), f32) * MLA_Q_LORA ** -0.5
    kv_a_norm = 1.0 + 0.05 * jax.random.normal(ks[6], (DEPTH, MLA_KV_LORA), f32)
    w_kv_b = jax.random.normal(ks[7], (DEPTH, MLA_KV_LORA, MLA_HEADS * (MLA_NOPE + MLA_V)), f32) * MLA_KV_LORA ** -0.5
    sinks = jax.random.normal(ks[8], (DEPTH, SWA_HEADS), f32)
    rel_bias = 0.5 * jax.random.normal(ks[9], (REL_BUCKETS, SWA_HEADS), f32)
    w_out = jax.random.normal(ks[10], (DEPTH, MIX_WIDTH, D_MODEL), f32) * MIX_WIDTH ** -0.5
    final_norm = 1.0 + 0.05 * jax.random.normal(ks[11], (D_MODEL,), f32)
    return {"x": x, "positions": positions, "norm_gain": norm_gain, "w_in": w_in,
            "q_a_norm": q_a_norm, "w_q_b": w_q_b, "kv_a_norm": kv_a_norm, "w_kv_b": w_kv_b,
            "sinks": sinks, "rel_bias": rel_bias, "w_out": w_out, "final_norm": final_norm}


def reference(x, positions, norm_gain, w_in, q_a_norm, w_q_b, kv_a_norm, w_kv_b,
              sinks, rel_bias, w_out, final_norm):
    offs = _offsets(IN_SPLITS)
    for layer in range(DEPTH):
        h = rmsnorm(x, norm_gain[layer])
        proj = h @ w_in[layer]
        q_lat, kv_lat, k_rope, q_s, k_s, v_s, gate = jnp.split(proj, offs, axis=-1)
        o_a = mla_group(q_lat, kv_lat, k_rope, positions, q_a_norm[layer], w_q_b[layer],
                        kv_a_norm[layer], w_kv_b[layer])
        o_b = swa_group(q_s, k_s, v_s, positions, rel_bias, sinks[layer])
        y = jnp.concatenate([o_a, o_b], axis=-1) * jax.nn.silu(gate)
        x = x + y @ w_out[layer]
    return rmsnorm(x, final_norm)
```

```cpp
#include <hip/hip_runtime.h>
#include <hip/hip_bf16.h>
#include <cstdio>
#include <cstdint>
#include <cmath>
namespace pg8 {
#define PG8_LAS __attribute__((address_space(3)))
typedef unsigned short bf16_t;
typedef short bf16x8 __attribute__((ext_vector_type(8)));
typedef float f32x4 __attribute__((ext_vector_type(4)));
typedef unsigned u32x4 __attribute__((ext_vector_type(4)));
constexpr int BM = 256, BK = 64, HALF = 128, HTB = HALF * BK * 2  , STAGE_BYTES = 8 * HTB, NXCD = 8, WGM = 8;

__host__ __device__ __forceinline__ int lds_byte(int r, int c) { const int st = (r >> 4) * 2 + (c >> 5), rr = r & 15, cc = c & 31, ob = rr * 64 + cc * 2; return st * 1024 + (ob ^ (((ob >> 9) & 1) << 5)); }
__host__ __device__ __forceinline__ void stage_rc(int b, int& R, int& C) { const int st = b / 1024, sb = b % 1024, swz = sb ^ (((sb >> 9) & 1) << 5); R = (st >> 1) * 16 + swz / 64; C = (st & 1) * 32 + (swz % 64) / 2; }
__host__ __device__ __forceinline__ int perm32(int rho) { const int n = rho >> 4, i = rho & 15; return 8 * (i >> 2) + 4 * n + (i & 3); }

struct Unit { int pm, pn; };
struct Gemm { const bf16_t* A; const bf16_t* Bt; int M, N, K; };

struct StaticOrder {
    int nM, nN, nwg, G, c;
    __host__ __device__ void init(int M, int N, int G_, int c_) { nM = M / BM; nN = N / BM; nwg = nM * nN; G = G_; c = c_; }
    __host__ __device__ bool next(int i, Unit& u) const {
        const long L = (long)i * G + c; if (L >= nwg) return false;
        int wgid = (int)L; { const int q = nwg / NXCD, r = nwg % NXCD, xcd = wgid % NXCD, off = wgid / NXCD; wgid = (xcd < r ? xcd * (q + 1) : r * (q + 1) + (xcd - r) * q) + off; }
        const int nig = WGM * nN, gid = wgid / nig, fm = gid * WGM, gsz = (nM - fm) < WGM ? (nM - fm) : WGM;
        u.pm = fm + ((wgid % nig) % gsz); u.pn = (wgid % nig) / gsz; return true;
    }
    __device__ __forceinline__ void a_ready(const Unit&) const {}
    __device__ __forceinline__ void done(const Unit&) const {}
};

__device__ __forceinline__ unsigned cvt_pk_bf16(float lo, float hi) { unsigned r; asm volatile("v_cvt_pk_bf16_f32 %0, %1, %2" : "=v"(r) : "v"(lo), "v"(hi)); return r; }
typedef float f32x2 __attribute__((ext_vector_type(2)));
typedef float f32x2 __attribute__((ext_vector_type(2)));
typedef unsigned u32x2 __attribute__((ext_vector_type(2)));
__device__ __forceinline__ u32x4 pack8(f32x4 v0, f32x4 v1) { u32x4 w; w.x = cvt_pk_bf16(v0[0], v0[1]); w.y = cvt_pk_bf16(v0[2], v0[3]); w.z = cvt_pk_bf16(v1[0], v1[1]); w.w = cvt_pk_bf16(v1[2], v1[3]); return w; }
__device__ __forceinline__ float silu_f(float v) { return v * __builtin_amdgcn_rcpf(1.0f + __builtin_amdgcn_exp2f(-1.4426950408889634f * v)); }
__device__ __forceinline__ float sq4(f32x4 v) { return (v[0] * v[0] + v[1] * v[1]) + (v[2] * v[2] + v[3] * v[3]); }

struct EpiProj {
    static constexpr bool PERM = true, AFTER_DRAIN = false;
    bf16_t *QL, *KVL, *KS, *VS, *KPE, *QS, *G; float *PQ, *PKV; const float *COS, *SIN; float qs_scale;
    __device__ __forceinline__ void operator()(const f32x4 (&acc)[2][2][4][2], const Unit& u, int wr, int wc, int fr, int fq) const {
        const int row0 = u.pm * BM + wr * 64 + fr, pn = u.pn, cw = wc * 32 + 8 * fq;
        if (pn == 0) {
#pragma unroll
            for (int ai = 0; ai < 2; ++ai)
#pragma unroll
                for (int m = 0; m < 4; ++m) { const size_t row = (size_t)(row0 + ai * HALF + m * 16); float s = 0.f;
#pragma unroll
                    for (int bj = 0; bj < 2; ++bj) { s += sq4(acc[ai][bj][m][0]) + sq4(acc[ai][bj][m][1]); *(u32x4*)(QL + row * 256 + bj * HALF + cw) = pack8(acc[ai][bj][m][0], acc[ai][bj][m][1]); }
                    s += __shfl_xor(s, 16); s += __shfl_xor(s, 32);
                    if (fq == 0) PQ[row * 4 + wc] = s; }
        } else if (pn == 1) {
#pragma unroll
            for (int ai = 0; ai < 2; ++ai)
#pragma unroll
                for (int m = 0; m < 4; ++m) { const size_t row = (size_t)(row0 + ai * HALF + m * 16);
                    float s = sq4(acc[ai][0][m][0]) + sq4(acc[ai][0][m][1]);
                    *(u32x4*)(KVL + row * 128 + cw) = pack8(acc[ai][0][m][0], acc[ai][0][m][1]);
                    *(u32x4*)(KS + row * 128 + cw) = pack8(acc[ai][1][m][0], acc[ai][1][m][1]);
                    s += __shfl_xor(s, 16); s += __shfl_xor(s, 32);
                    if (fq == 0) PKV[row * 4 + wc] = s; }
        } else if (pn == 2) {
#pragma unroll
            for (int ai = 0; ai < 2; ++ai)
#pragma unroll
                for (int m = 0; m < 4; ++m) { const size_t row = (size_t)(row0 + ai * HALF + m * 16);
                    *(u32x4*)(VS + row * 128 + cw) = pack8(acc[ai][0][m][0], acc[ai][0][m][1]);
                    if (wc == 0) { const f32x4 c = *(const f32x4*)(COS + row * 16 + 4 * fq), s = *(const f32x4*)(SIN + row * 16 + 4 * fq);
                        const f32x4 x1 = acc[ai][1][m][0], x2 = acc[ai][1][m][1];
                        *(u32x4*)(KPE + row * 32 + 8 * fq) = pack8(x1 * c - x2 * s, x2 * c + x1 * s); }
                    asm volatile("" ::: "memory"); }
        } else if (pn < 5) {
            const int c0 = (pn - 3) * 256 + cw;
#pragma unroll
            for (int ai = 0; ai < 2; ++ai)
#pragma unroll
                for (int m = 0; m < 4; ++m) { const size_t row = (size_t)(row0 + ai * HALF + m * 16);
#pragma unroll
                    for (int bj = 0; bj < 2; ++bj) *(u32x4*)(QS + row * 512 + c0 + bj * HALF) = pack8(acc[ai][bj][m][0] * qs_scale, acc[ai][bj][m][1] * qs_scale); }
        } else {
            const int c0 = (pn - 5) * 256 + cw;
#pragma unroll
            for (int ai = 0; ai < 2; ++ai)
#pragma unroll
                for (int m = 0; m < 4; ++m) { const size_t row = (size_t)(row0 + ai * HALF + m * 16);
#pragma unroll
                    for (int bj = 0; bj < 2; ++bj) { f32x4 a = acc[ai][bj][m][0], b = acc[ai][bj][m][1];
#pragma unroll
                        for (int j = 0; j < 4; ++j) { a[j] = silu_f(a[j]); b[j] = silu_f(b[j]); }
                        *(u32x4*)(G + row * 1024 + c0 + bj * HALF) = pack8(a, b); } }
        }
    }
};
struct EpiRS {
    static constexpr bool PERM = true, AFTER_DRAIN = false;
    bf16_t *D0, *D1; int p1; const float* PP; float inv_n, scale, eps;
    __device__ __forceinline__ void operator()(const f32x4 (&acc)[2][2][4][2], const Unit& u, int wr, int wc, int fr, int fq) const {
        const int row0 = u.pm * BM + wr * 64 + fr, pn = u.pn, cw = wc * 32 + 8 * fq;
        bf16_t* dst = (pn < 2) ? D0 : D1; const int pitch = (pn < 2) ? 512 : p1, c0 = (pn & 1) * 256 + cw;
#pragma unroll
        for (int ai = 0; ai < 2; ++ai)
#pragma unroll
            for (int m = 0; m < 4; ++m) { const size_t row = (size_t)(row0 + ai * HALF + m * 16);
                const f32x4 pq = *(const f32x4*)(PP + row * 4);
                const float rs = __builtin_amdgcn_rsqf(((pq[0] + pq[1]) + (pq[2] + pq[3])) * inv_n + eps) * scale;
#pragma unroll
                for (int bj = 0; bj < 2; ++bj) *(u32x4*)(dst + row * pitch + c0 + bj * HALF) = pack8(acc[ai][bj][m][0] * rs, acc[ai][bj][m][1] * rs);
                asm volatile("" ::: "memory"); }
    }
};
struct EpiOut {
    static constexpr bool PERM = false, AFTER_DRAIN = false;
    const float* X; float* O;
    __device__ __forceinline__ void operator()(const f32x4 (&acc)[2][2][4][2], const Unit& u, int wr, int wc, int fr, int fq) const {
        const int row0 = u.pm * BM + wr * 64 + fr, col0 = u.pn * BM + wc * 32 + 4 * fq;
#pragma unroll
        for (int ai = 0; ai < 2; ++ai)
#pragma unroll
            for (int m = 0; m < 4; ++m) { const size_t off = (size_t)(row0 + ai * HALF + m * 16) * 1024 + col0;
#pragma unroll
                for (int bj = 0; bj < 2; ++bj)
#pragma unroll
                    for (int n = 0; n < 2; ++n) { const f32x4 xv = *(const f32x4*)(X + off + bj * HALF + n * 16); *(f32x4*)(O + off + bj * HALF + n * 16) = xv + acc[ai][bj][m][n]; }
                if (m & 1) asm volatile("" ::: "memory"); }
    }
};
template <class Epi, class Sched, bool ALIGN_EPI = false, bool SP2 = false>
__device__ __forceinline__ void gemm_phase(PG8_LAS unsigned char* lds, const Gemm g, const Sched& S, const Epi& E) {
    const int tid = threadIdx.x, wid = __builtin_amdgcn_readfirstlane(tid >> 6), lane = tid & 63, wr = wid >> 2, wc = wid & 3, fr = lane & 15, fq = lane >> 4;
    const int K = g.K, nt = K / BK;
    unsigned voffA[2], voffB[2];
#pragma unroll
    for (int i = 0; i < 2; ++i) { int R, C; stage_rc(tid * 16 + i * 8192, R, C); const int Rb = Epi::PERM ? ((R & ~31) + perm32(R & 31)) : R;
        voffA[i] = (unsigned)(R * K + C) * 2u; voffB[i] = (unsigned)(Rb * K + C) * 2u; }
    const size_t kstep = (size_t)(BK * 2);
    const size_t hstep = (size_t)HALF * K * 2;
    const size_t tstep = 2 * hstep;
    const unsigned ldsw = (unsigned)wid * 1024u;
    const int aoff = lds_byte(wr * 64 + fr, fq * 8), boff = lds_byte(wc * 32 + fr, fq * 8);
#define PG8_SA(b, h) (((b) * 2 + (h)) * HTB)
#define PG8_SB(b, h) ((4 + (b) * 2 + (h)) * HTB)
#define PG8_STAGE(bufoff, gbase, voff) do { _Pragma("unroll") for (int _i = 0; _i < 2; ++_i) \
        __builtin_amdgcn_global_load_lds((const unsigned*)((const char*)(gbase) + (voff)[_i]), (PG8_LAS unsigned*)(lds + (bufoff) + ldsw + _i * 8192), 16, 0, 0); } while (0)
#define PG8_LDA(dst, b, h) do { _Pragma("unroll") for (int m = 0; m < 4; ++m) _Pragma("unroll") for (int k = 0; k < 2; ++k) dst[m][k] = *(const PG8_LAS bf16x8*)(lds + PG8_SA(b, h) + aoff + m * 2048 + k * 1024); } while (0)
#define PG8_LDB(dst, b, h) do { _Pragma("unroll") for (int n = 0; n < 2; ++n) _Pragma("unroll") for (int k = 0; k < 2; ++k) dst[n][k] = *(const PG8_LAS bf16x8*)(lds + PG8_SB(b, h) + boff + n * 2048 + k * 1024); } while (0)
#define PG8_MMA(ai, bj, At, Bt) do { __builtin_amdgcn_s_setprio(1); _Pragma("unroll") for (int m = 0; m < 4; ++m) _Pragma("unroll") for (int n = 0; n < 2; ++n) _Pragma("unroll") for (int k = 0; k < 2; ++k) \
        acc[ai][bj][m][n] = __builtin_amdgcn_mfma_f32_16x16x32_bf16(Bt[n][k], At[m][k], acc[ai][bj][m][n], 0, 0, 0); __builtin_amdgcn_s_setprio(0); } while (0)
#define PG8_WAIT_V(n) asm volatile("s_waitcnt vmcnt(" #n ")" ::: "memory")
#define PG8_WAIT_L(n) asm volatile("s_waitcnt lgkmcnt(" #n ")" ::: "memory")
#define PG8_BAR __builtin_amdgcn_s_barrier()
#define PG8_SCHED __builtin_amdgcn_sched_barrier(0)
    Unit cur, nxt; int ui = 0;
    if (!S.next(0, cur)) return;
    f32x4 acc[2][2][4][2];
#pragma unroll
    for (int a = 0; a < 2; ++a)
#pragma unroll
        for (int b = 0; b < 2; ++b)
#pragma unroll
            for (int m = 0; m < 4; ++m)
#pragma unroll
                for (int n = 0; n < 2; ++n) acc[a][b][m][n] = (f32x4){0.f, 0.f, 0.f, 0.f};
    bf16x8 At[4][2], B0[2][2], B1[2][2];
    const char* cA = (const char*)g.A + (size_t)cur.pm * tstep; const char* cB = (const char*)g.Bt + (size_t)cur.pn * tstep;
    S.a_ready(cur);
    if constexpr (SP2) {
        PG8_STAGE(PG8_SB(0, 0), cB, voffB); PG8_STAGE(PG8_SB(0, 1), cB + hstep, voffB); PG8_STAGE(PG8_SA(0, 0), cA, voffA); PG8_STAGE(PG8_SA(0, 1), cA + hstep, voffA);
        if (wr == 1) PG8_BAR;
        PG8_WAIT_V(2); PG8_BAR;
        PG8_STAGE(PG8_SB(1, 0), cB + kstep, voffB); PG8_STAGE(PG8_SA(1, 0), cA + kstep, voffA); PG8_STAGE(PG8_SB(1, 1), cB + hstep + kstep, voffB);
        PG8_WAIT_V(6); PG8_BAR;
    } else {
        PG8_STAGE(PG8_SB(0, 0), cB, voffB); PG8_STAGE(PG8_SA(0, 0), cA, voffA); PG8_STAGE(PG8_SB(0, 1), cB + hstep, voffB); PG8_STAGE(PG8_SA(0, 1), cA + hstep, voffA);
        if (wr == 1) PG8_BAR;
        PG8_WAIT_V(4); PG8_BAR;
        PG8_STAGE(PG8_SB(1, 0), cB + kstep, voffB); PG8_STAGE(PG8_SA(1, 0), cA + kstep, voffA); PG8_STAGE(PG8_SB(1, 1), cB + hstep + kstep, voffB);
        PG8_WAIT_V(6); PG8_BAR;
    }
    for (;;) {
        const bool has_next = S.next(ui + 1, nxt);
        const char* nA = has_next ? (const char*)g.A + (size_t)nxt.pm * tstep : cA; const char* nB = has_next ? (const char*)g.Bt + (size_t)nxt.pn * tstep : cB;
        for (int t = 0; t < nt; t += 2) {
            const bool last = (t == nt - 2);
            const char* a1 = cA + (size_t)(t + 1) * kstep;
            const char* a2 = last ? nA : cA + (size_t)(t + 2) * kstep; const char* b2 = last ? nB : cB + (size_t)(t + 2) * kstep;
            const char* a3 = a2 + kstep; const char* b3 = b2 + kstep;
            if (last && has_next) S.a_ready(nxt);
            if constexpr (SP2) {
            PG8_LDB(B0, 0, 0); PG8_LDB(B1, 0, 1); PG8_SCHED; PG8_LDA(At, 0, 0); PG8_STAGE(PG8_SA(1, 1), a1 + hstep, voffA);
            PG8_WAIT_V(8); PG8_WAIT_L(0); PG8_BAR; PG8_MMA(0, 0, At, B0); PG8_MMA(0, 1, At, B1); PG8_BAR; PG8_SCHED;
            PG8_LDA(At, 0, 1); PG8_STAGE(PG8_SB(0, 0), b2, voffB); PG8_STAGE(PG8_SB(0, 1), b2 + hstep, voffB); PG8_STAGE(PG8_SA(0, 0), a2, voffA);
            PG8_WAIT_V(8); PG8_WAIT_L(0); PG8_BAR; PG8_MMA(1, 0, At, B0); PG8_MMA(1, 1, At, B1); PG8_BAR; PG8_SCHED;
            PG8_LDB(B0, 1, 0); PG8_LDB(B1, 1, 1); PG8_SCHED; PG8_LDA(At, 1, 0); PG8_STAGE(PG8_SA(0, 1), a2 + hstep, voffA);
            PG8_WAIT_V(8); PG8_WAIT_L(0); PG8_BAR; PG8_MMA(0, 0, At, B0); PG8_MMA(0, 1, At, B1); PG8_BAR; PG8_SCHED;
            PG8_LDA(At, 1, 1); PG8_STAGE(PG8_SB(1, 0), b3, voffB); PG8_STAGE(PG8_SB(1, 1), b3 + hstep, voffB); PG8_STAGE(PG8_SA(1, 0), a3, voffA);
            PG8_WAIT_V(8); PG8_WAIT_L(0); PG8_BAR; PG8_MMA(1, 0, At, B0); PG8_MMA(1, 1, At, B1); PG8_BAR; PG8_SCHED;
            } else {
            PG8_LDB(B0, 0, 0); PG8_SCHED; PG8_LDA(At, 0, 0); PG8_STAGE(PG8_SA(1, 1), a1 + hstep, voffA);
            PG8_WAIT_L(8); PG8_BAR; PG8_WAIT_L(0); PG8_MMA(0, 0, At, B0); PG8_BAR; PG8_SCHED;
            PG8_LDB(B1, 0, 1); PG8_STAGE(PG8_SB(0, 0), b2, voffB);
            PG8_BAR; PG8_WAIT_L(0); PG8_MMA(0, 1, At, B1); PG8_BAR;
            PG8_LDA(At, 0, 1); PG8_STAGE(PG8_SA(0, 0), a2, voffA);
            PG8_BAR; PG8_WAIT_L(0); PG8_MMA(1, 0, At, B0); PG8_BAR; PG8_SCHED;
            PG8_STAGE(PG8_SB(0, 1), b2 + hstep, voffB);
            PG8_WAIT_V(6); PG8_BAR; PG8_MMA(1, 1, At, B1); PG8_BAR;
            PG8_LDB(B0, 1, 0); PG8_SCHED; PG8_LDA(At, 1, 0); PG8_STAGE(PG8_SA(0, 1), a2 + hstep, voffA);
            PG8_WAIT_L(8); PG8_BAR; PG8_WAIT_L(0); PG8_MMA(0, 0, At, B0); PG8_BAR; PG8_SCHED;
            PG8_LDB(B1, 1, 1); PG8_STAGE(PG8_SB(1, 0), b3, voffB);
            PG8_BAR; PG8_WAIT_L(0); PG8_MMA(0, 1, At, B1); PG8_BAR;
            PG8_LDA(At, 1, 1); PG8_STAGE(PG8_SA(1, 0), a3, voffA);
            PG8_BAR; PG8_WAIT_L(0); PG8_MMA(1, 0, At, B0); PG8_BAR; PG8_SCHED;
            PG8_STAGE(PG8_SB(1, 1), b3 + hstep, voffB);
            PG8_WAIT_V(6); PG8_BAR; PG8_MMA(1, 1, At, B1); PG8_BAR;
            }
        }
        if constexpr (ALIGN_EPI) { if (wr == 0) PG8_BAR; }
        if constexpr (!Epi::AFTER_DRAIN) { E(acc, cur, wr, wc, fr, fq); S.done(cur); }
        if (!has_next) break;
#pragma unroll
        for (int a = 0; a < 2; ++a)
#pragma unroll
            for (int b = 0; b < 2; ++b)
#pragma unroll
                for (int m = 0; m < 4; ++m)
#pragma unroll
                    for (int n = 0; n < 2; ++n) acc[a][b][m][n] = (f32x4){0.f, 0.f, 0.f, 0.f};
        cur = nxt; cA = nA; cB = nB; ++ui;
        if constexpr (ALIGN_EPI) { if (wr == 1) PG8_BAR; }
    }
    PG8_WAIT_V(0);
    if constexpr (!ALIGN_EPI) { if (wr == 0) PG8_BAR; }
    PG8_BAR;
    if constexpr (Epi::AFTER_DRAIN) { E.fused(acc, cur, wr, wc, fr, fq, lds, wid, lane); S.done(cur); }
#undef PG8_SA
#undef PG8_SB
#undef PG8_STAGE
#undef PG8_LDA
#undef PG8_LDB
#undef PG8_MMA
#undef PG8_WAIT_V
#undef PG8_WAIT_L
#undef PG8_BAR
#undef PG8_SCHED
}
}
#ifndef PG8_SP2
#define PG8_SP2 true
#endif
#ifndef PG8_ALIGN
#define PG8_ALIGN true
#endif
namespace att {
using bf16x8 = __attribute__((ext_vector_type(8))) short;
using s16x4 = __attribute__((ext_vector_type(4))) short;
using f32x16 = __attribute__((ext_vector_type(16))) float;
using u32x4 = __attribute__((ext_vector_type(4))) unsigned;
using f32x4 = __attribute__((ext_vector_type(4))) float;
typedef unsigned short bf16_t;
#define ALDS __attribute__((address_space(3)))
#define SBAR() __builtin_amdgcn_sched_barrier(0)
constexpr int SEQ = 8192, NBATCH = 4;
constexpr float LOG2E = 1.4426950408889634f;
__device__ __forceinline__ int crow(int r, int hi) { return (r & 3) + 8 * (r >> 2) + 4 * hi; }
typedef float f32x2_t __attribute__((ext_vector_type(2))); typedef __bf16 bf16x2_t __attribute__((ext_vector_type(2)));
__device__ __forceinline__ unsigned cvtpk_s(float lo, float hi) { f32x2_t v = {lo, hi}; bf16x2_t b = __builtin_convertvector(v, bf16x2_t); return __builtin_bit_cast(unsigned, b); }
__device__ __forceinline__ float bf_lo(unsigned w) { return __uint_as_float(w << 16); }
__device__ __forceinline__ float bf_hi(unsigned w) { return __uint_as_float(w & 0xffff0000u); }
#define MX3(a, b, c) __builtin_fmaxf(__builtin_fmaxf((a), (b)), (c))
__device__ __forceinline__ float rowmax(const f32x16& p0, const f32x16& p1) {
    float a = MX3(p0[0], p0[1], p1[0]), b = MX3(p0[2], p0[3], p1[1]); a = MX3(a, p1[2], p1[3]);
#pragma unroll
    for (int r = 4; r < 16; r += 4) { a = MX3(a, p0[r], p0[r + 1]); b = MX3(b, p0[r + 2], p0[r + 3]); a = MX3(a, p1[r], p1[r + 1]); b = MX3(b, p1[r + 2], p1[r + 3]); }
    float m = __builtin_fmaxf(a, b); auto rr = __builtin_amdgcn_permlane32_swap(__float_as_uint(m), __float_as_uint(m), false, false);
    return __builtin_fmaxf(__uint_as_float(rr[0]), __uint_as_float(rr[1])); }
template <int NDS> __device__ __forceinline__ void qkt(f32x16& p0, f32x16& p1, const ALDS char* Kslot, const bf16x8* qr, int r32, int hi) {
    const ALDS char* kb = Kslot + hi * 1024 + r32 * 16;
    p0 = f32x16{}; p1 = f32x16{};
#pragma unroll
    for (int d0 = 0; d0 < NDS; ++d0) {
        const bf16x8 b0 = *(const ALDS bf16x8*)(kb + d0 * 2048), b1 = *(const ALDS bf16x8*)(kb + d0 * 2048 + 512);
        p0 = __builtin_amdgcn_mfma_f32_32x32x16_bf16(b0, qr[d0], p0, 0, 0, 0); p1 = __builtin_amdgcn_mfma_f32_32x32x16_bf16(b1, qr[d0], p1, 0, 0, 0); }
}
__device__ __forceinline__ void pv(f32x16* o, int vb, bf16x8 pa0, bf16x8 pa1, bf16x8 pa2, bf16x8 pa3) {
#pragma unroll
    for (int d0 = 0; d0 < 2; ++d0) { s16x4 lo[4], hi[4];
#pragma unroll
        for (int ks = 0; ks < 4; ++ks) {
            asm volatile("ds_read_b64_tr_b16 %0,%1 offset:%c2" : "=&v"(lo[ks]) : "v"(vb), "i"(d0 * 4096 + ks * 1024) : "memory");
            asm volatile("ds_read_b64_tr_b16 %0,%1 offset:%c2" : "=&v"(hi[ks]) : "v"(vb), "i"(d0 * 4096 + ks * 1024 + 512) : "memory"); }
        asm volatile("s_waitcnt lgkmcnt(0)" ::: "memory"); SBAR();
#define PK(k) (bf16x8){lo[k][0], lo[k][1], lo[k][2], lo[k][3], hi[k][0], hi[k][1], hi[k][2], hi[k][3]}
        o[d0] = __builtin_amdgcn_mfma_f32_32x32x16_bf16(pa0, PK(0), o[d0], 0, 0, 0);
        o[d0] = __builtin_amdgcn_mfma_f32_32x32x16_bf16(pa1, PK(1), o[d0], 0, 0, 0);
        o[d0] = __builtin_amdgcn_mfma_f32_32x32x16_bf16(pa2, PK(2), o[d0], 0, 0, 0);
        o[d0] = __builtin_amdgcn_mfma_f32_32x32x16_bf16(pa3, PK(3), o[d0], 0, 0, 0);
#undef PK
    }
}
__device__ __forceinline__ void softmax_pv(f32x16& p0, f32x16& p1, float& m, float& l, f32x16* o, ALDS float* wsf, int vb, int r32, int hi) {
    const float rm = rowmax(p0, p1), mn = __builtin_fmaxf(m, rm), alpha = __builtin_amdgcn_exp2f(m - mn); m = mn;
    float ls = 0.f;
#pragma unroll
    for (int r = 0; r < 16; ++r) { p0[r] = __builtin_amdgcn_exp2f(p0[r] - mn); p1[r] = __builtin_amdgcn_exp2f(p1[r] - mn); ls += p0[r] + p1[r]; }
    l = l * alpha + ls;
    if (hi == 0) wsf[r32] = alpha;
    asm volatile("s_waitcnt lgkmcnt(0)" ::: "memory");
#pragma unroll
    for (int d = 0; d < 2; ++d)
#pragma unroll
        for (int r = 0; r < 16; ++r) o[d][r] *= wsf[crow(r, hi)];
    u32x4 pw0 = {cvtpk_s(p0[0], p0[1]), cvtpk_s(p0[2], p0[3]), cvtpk_s(p0[4], p0[5]), cvtpk_s(p0[6], p0[7])};
    u32x4 pw1 = {cvtpk_s(p0[8], p0[9]), cvtpk_s(p0[10], p0[11]), cvtpk_s(p0[12], p0[13]), cvtpk_s(p0[14], p0[15])};
    u32x4 pw2 = {cvtpk_s(p1[0], p1[1]), cvtpk_s(p1[2], p1[3]), cvtpk_s(p1[4], p1[5]), cvtpk_s(p1[6], p1[7])};
    u32x4 pw3 = {cvtpk_s(p1[8], p1[9]), cvtpk_s(p1[10], p1[11]), cvtpk_s(p1[12], p1[13]), cvtpk_s(p1[14], p1[15])};
    asm volatile("s_waitcnt lgkmcnt(0)" ::: "memory"); SBAR();
    pv(o, vb, __builtin_bit_cast(bf16x8, pw0), __builtin_bit_cast(bf16x8, pw1), __builtin_bit_cast(bf16x8, pw2), __builtin_bit_cast(bf16x8, pw3));
}
__device__ __forceinline__ void attn_epilogue(const f32x16* o, float l, ALDS float* wsf, ALDS bf16_t* stg, const bf16_t* G, bf16_t* Y, size_t grow, int ycol, int lane, int r32, int hi) {
    { auto rr = __builtin_amdgcn_permlane32_swap(__float_as_uint(l), __float_as_uint(l), false, false); l = __uint_as_float(rr[0]) + __uint_as_float(rr[1]); }
    if (hi == 0) wsf[32 + r32] = l;
    asm volatile("s_waitcnt lgkmcnt(0)" ::: "memory");
    float rli[16];
#pragma unroll
    for (int r = 0; r < 16; ++r) rli[r] = __builtin_amdgcn_rcpf(wsf[32 + crow(r, hi)]);
#pragma unroll
    for (int r = 0; r < 16; ++r) { const int orow = crow(r, hi);
#pragma unroll
        for (int d0 = 0; d0 < 2; ++d0) { const float v = o[d0][r] * rli[r]; stg[orow * 64 + d0 * 32 + r32] = (bf16_t)(cvtpk_s(v, v) & 0xffffu); } }
    asm volatile("s_waitcnt lgkmcnt(0)" ::: "memory");
#pragma unroll
    for (int i = 0; i < 4; ++i) { const int row = i * 8 + (lane >> 3), ch = lane & 7;
        const u32x4 v = *(const ALDS u32x4*)(stg + row * 64 + ch * 8);
        const size_t off = (grow + row) * 1024 + ycol + ch * 8;
        const u32x4 g = *(const u32x4*)(G + off); u32x4 y;
#pragma unroll
        for (int k = 0; k < 4; ++k) y[k] = cvtpk_s(bf_lo(v[k]) * bf_lo(g[k]), bf_hi(v[k]) * bf_hi(g[k]));
        *(u32x4*)(Y + off) = y; }
    asm volatile("s_waitcnt lgkmcnt(0)" ::: "memory");
}

struct AttnPtrs { const bf16_t *QN, *QPE, *KN, *KPE, *V, *QS, *KS, *VS, *G; bf16_t* Y; const int* pos; const float *sinks, *relb, *COS, *SIN; };
constexpr int A_KV = 0;
constexpr int A_MLA_SLOT = 20480, A_MLA_V = 12288;
constexpr int A_SWA_V = 32768;
constexpr int A_WSF = 65536;
constexpr int A_OST = A_WSF + 8 * 256;
constexpr int A_KPOS = A_OST + 8 * 4096;
constexpr int A_TAB = A_KPOS + 1024;
constexpr int A_END = A_TAB + 4 * 132 * 4;

__device__ __forceinline__ void mla_unit(int b, int h, int qb, const AttnPtrs& P, ALDS char* shm) {
    const int tid = threadIdx.x, lane = tid & 63, r32 = lane & 31, hi = lane >> 5; const int wid = __builtin_amdgcn_readfirstlane(tid >> 6);
    const size_t rowbase = (size_t)b * SEQ; const int q0 = qb * 256, NT = (q0 + 256) / 64;
    const size_t qrow = rowbase + q0 + wid * 32 + r32;
    bf16x8 qr[6];
#pragma unroll
    for (int d0 = 0; d0 < 4; ++d0) qr[d0] = *(const bf16x8*)(P.QN + qrow * 512 + h * 64 + d0 * 16 + hi * 8);
#pragma unroll
    for (int d0 = 0; d0 < 2; ++d0) {
        const u32x4 w = *(const u32x4*)(P.QPE + qrow * 256 + h * 32 + d0 * 16 + hi * 8);
        const f32x4 c = *(const f32x4*)(P.COS + qrow * 16 + 4 * (2 * d0 + hi)), s = *(const f32x4*)(P.SIN + qrow * 16 + 4 * (2 * d0 + hi));
        const f32x4 x1 = {bf_lo(w[0]), bf_hi(w[0]), bf_lo(w[1]), bf_hi(w[1])}, x2 = {bf_lo(w[2]), bf_hi(w[2]), bf_lo(w[3]), bf_hi(w[3])};
        const f32x4 o1 = x1 * c - x2 * s, o2 = x2 * c + x1 * s;
        const u32x4 r = {cvtpk_s(o1[0], o1[1]), cvtpk_s(o1[2], o1[3]), cvtpk_s(o2[0], o2[1]), cvtpk_s(o2[2], o2[3])};
        qr[4 + d0] = __builtin_bit_cast(bf16x8, r); }
    const bf16_t* ksrc = P.KN + (rowbase + lane) * 512 + h * 64 + wid * 8;
    const bf16_t* kpsrc = P.KPE + (rowbase + lane) * 32 + (wid & 3) * 8;
    const bf16_t* vsrc = P.V + (rowbase + 16 * (wid & 3) + (lane >> 2)) * 512 + h * 64 + (wid >> 2) * 32 + (lane & 3) * 8;
    const int kdst = wid * 1024 + lane * 16, kpdst = (8 + (wid & 3)) * 1024 + lane * 16, vdst = A_MLA_V + wid * 1024 + lane * 16;
    ALDS float* wsf = (ALDS float*)(shm + A_WSF) + wid * 64;
    ALDS bf16_t* stg = (ALDS bf16_t*)(shm + A_OST) + wid * 2048;
    const int vb0 = (int)(unsigned)(uintptr_t)(shm + A_KV + A_MLA_V) + ((lane >> 4) & 1) * 32 + (lane & 3) * 8 + (4 * hi + ((lane & 15) >> 2)) * 64;
    float m = -1e30f, l = 0.f; f32x16 o[2]; o[0] = f32x16{}; o[1] = f32x16{};
    const int qrel = wid * 32 + r32;
    u32x4 kreg, kpreg = {0, 0, 0, 0}, vreg;
    kreg = *(const u32x4*)(ksrc); if (wid < 4) kpreg = *(const u32x4*)(kpsrc); vreg = *(const u32x4*)(vsrc);
    *(ALDS u32x4*)(shm + A_KV + kdst) = kreg; if (wid < 4) *(ALDS u32x4*)(shm + A_KV + kpdst) = kpreg; *(ALDS u32x4*)(shm + A_KV + vdst) = vreg;
    __syncthreads();
    for (int t = 0; t < NT; ++t) {
        const int boff = A_KV + (t & 1) * A_MLA_SLOT, noff = A_KV + ((t + 1) & 1) * A_MLA_SLOT;
        if (t + 1 < NT) { kreg = *(const u32x4*)(ksrc + (size_t)(t + 1) * 64 * 512); if (wid < 4) kpreg = *(const u32x4*)(kpsrc + (size_t)(t + 1) * 64 * 32); vreg = *(const u32x4*)(vsrc + (size_t)(t + 1) * 64 * 512); }
        f32x16 p0, p1;
        qkt<6>(p0, p1, shm + boff, qr, r32, hi);
        const int jb = t - (NT - 4);
        if (jb >= 0) { const int kb = 64 * jb + 4 * hi;
#pragma unroll
            for (int r = 0; r < 16; ++r) { const int kv = kb + (r & 3) + 8 * (r >> 2); if (kv > qrel) p0[r] = -INFINITY; if (kv + 32 > qrel) p1[r] = -INFINITY; } }
        softmax_pv(p0, p1, m, l, o, wsf, vb0 + (t & 1) * A_MLA_SLOT, r32, hi);
        if (t + 1 < NT) { *(ALDS u32x4*)(shm + noff + kdst) = kreg; if (wid < 4) *(ALDS u32x4*)(shm + noff + kpdst) = kpreg; *(ALDS u32x4*)(shm + noff + vdst) = vreg; }
        __syncthreads();
    }
    attn_epilogue(o, l, wsf, stg, P.G, P.Y, rowbase + q0 + wid * 32, h * 64, lane, r32, hi);
}

__device__ __forceinline__ int t5_bucket(int n) {
    if (n < 16) return n;
    const int large = 16 + (int)(__logf((float)n * (1.0f / 16.0f)) / 2.0794415416798357f * 16.0f);
    return large < 31 ? large : 31;
}
__device__ __forceinline__ void swa_unit(int b, int kvh, int blk, const AttnPtrs& P, ALDS char* shm) {
    const int tid = threadIdx.x, lane = tid & 63, r32 = lane & 31, hi = lane >> 5; const int wid = __builtin_amdgcn_readfirstlane(tid >> 6);
    const size_t rowbase = (size_t)b * SEQ; const int kb0 = blk * 128 - 128;
    ALDS int* kposL = (ALDS int*)(shm + A_KPOS); ALDS float* tab = (ALDS float*)(shm + A_TAB);
    const int t_first = (blk == 0) ? 2 : 0;
    for (int tt = t_first; tt < 4; ++tt) {
        const size_t krow = rowbase + kb0 + tt * 64;
        const u32x4 kreg = *(const u32x4*)(P.KS + (krow + lane) * 128 + kvh * 64 + wid * 8);
        const u32x4 vreg = *(const u32x4*)(P.VS + (krow + 16 * (wid & 3) + (lane >> 2)) * 128 + kvh * 64 + (wid >> 2) * 32 + (lane & 3) * 8);
        *(ALDS u32x4*)(shm + A_KV + tt * 8192 + wid * 1024 + lane * 16) = kreg;
        *(ALDS u32x4*)(shm + A_SWA_V + tt * 8192 + wid * 1024 + lane * 16) = vreg;
    }
    if (tid < 256) kposL[tid] = (kb0 + tid >= 0) ? P.pos[rowbase + kb0 + tid] : 0;
    for (int i = tid; i < 4 * 129; i += 512) { const int g = i / 129, n = i - g * 129; tab[g * 132 + n] = P.relb[t5_bucket(n) * 8 + kvh * 4 + g] * LOG2E; }
    __syncthreads();
    ALDS float* wsf = (ALDS float*)(shm + A_WSF) + wid * 64;
    ALDS bf16_t* stg = (ALDS bf16_t*)(shm + A_OST) + wid * 2048;
    const int g = wid & 3, hq = kvh * 4 + g;
    const int vb0 = (int)(unsigned)(uintptr_t)(shm + A_SWA_V) + ((lane >> 4) & 1) * 32 + (lane & 3) * 8 + (4 * hi + ((lane & 15) >> 2)) * 64;
    const float sink2 = P.sinks[hq] * LOG2E;
    for (int jj = 0; jj < 2; ++jj) {
        const int j = (wid >> 2) * 2 + jj;
        const size_t qrow = rowbase + blk * 128 + j * 32 + r32;
        bf16x8 qr[4];
#pragma unroll
        for (int d0 = 0; d0 < 4; ++d0) qr[d0] = *(const bf16x8*)(P.QS + qrow * 512 + hq * 64 + d0 * 16 + hi * 8);
        const int qpos = P.pos[qrow], qband = 128 + j * 32 + r32;
        float m = sink2, l = (hi == 0) ? 1.0f : 0.0f; f32x16 o[2]; o[0] = f32x16{}; o[1] = f32x16{};
        const int tlo = (wid >> 2);
        for (int tt = tlo; tt < tlo + 3; ++tt) {
            if (tt < t_first) continue;
            f32x16 p0, p1;
            qkt<4>(p0, p1, shm + A_KV + tt * 8192, qr, r32, hi);
#pragma unroll
            for (int r = 0; r < 16; ++r) {
#pragma unroll
                for (int hf = 0; hf < 2; ++hf) {
                    const int kk = tt * 64 + crow(r, hi) + 32 * hf, delta = qband - kk;
                    int n = qpos - kposL[kk]; n = n < 0 ? 0 : (n > 128 ? 128 : n);
                    const float bias = tab[g * 132 + n];
                    const float s = (hf ? p1[r] : p0[r]) + bias;
                    const float v = (delta >= 0 && delta < 128) ? s : -INFINITY;
                    if (hf) p1[r] = v; else p0[r] = v; } }
            softmax_pv(p0, p1, m, l, o, wsf, vb0 + tt * 8192, r32, hi);
        }
        attn_epilogue(o, l, wsf, stg, P.G, P.Y, rowbase + blk * 128 + j * 32, 512 + hq * 64, lane, r32, hi);
    }
    __syncthreads();
}
}
#define GAS __attribute__((address_space(1)))
#define LAS __attribute__((address_space(3)))
typedef unsigned short bf16;
typedef unsigned v4u __attribute__((ext_vector_type(4)));
typedef float f32x4 __attribute__((ext_vector_type(4)));
typedef short bf16x8 __attribute__((ext_vector_type(8)));
typedef GAS unsigned gu32;
typedef GAS unsigned long long gu64;
#define RLX_AGENT __ATOMIC_RELAXED, __HIP_MEMORY_SCOPE_AGENT
#define LDS_WAIT() asm volatile("s_waitcnt lgkmcnt(0)" ::: "memory")
#define VM_WAIT() asm volatile("s_waitcnt vmcnt(0)" ::: "memory")
__device__ __forceinline__ unsigned long long rt() { return __builtin_amdgcn_s_memrealtime(); }
__device__ __forceinline__ unsigned f2bf(float f) { unsigned u = __builtin_bit_cast(unsigned, f); return (u + 0x7fffu + ((u >> 16) & 1u)) >> 16; }
__device__ __forceinline__ unsigned pk2(float lo, float hi) { return f2bf(lo) | (f2bf(hi) << 16); }

#define XB_TMO      128
#define XB_XCNT(j)  (256  + 64 * (j))
#define XB_XSUB(j)  (1280 + 64 * (j))
#define XB_XGEN(j)  (2304 + 64 * (j))
#define XB_TOP      3328
#define XB_TOPGEN   3392
#define XCD_BAR_WORDS 3456
#define XB_SPIN_CAP (1u << 18)

__device__ __forceinline__ unsigned xb_ld(unsigned* p)              { return __hip_atomic_load(p, __ATOMIC_RELAXED, __HIP_MEMORY_SCOPE_AGENT); }
__device__ __forceinline__ unsigned xb_add(unsigned* p, unsigned v) { return __hip_atomic_fetch_add(p, v, __ATOMIC_RELAXED, __HIP_MEMORY_SCOPE_AGENT); }
__device__ __forceinline__ unsigned xb_xcc_id() { return (unsigned)__builtin_amdgcn_s_getreg((3 << 11) | 20) & 0xFu; }
#define XB_SPIN(cond, bar) do { unsigned _sp = 0; while (cond) { __builtin_amdgcn_s_sleep(1); \
    if ((++_sp & 255u) == 0u) { if (xb_ld(&(bar)[XB_TMO])) break; if (_sp > XB_SPIN_CAP) { atomicAdd(&(bar)[XB_TMO], 1u); break; } } } } while (0)

struct XcdBarrier {
    unsigned* bar; unsigned x;
    volatile LAS unsigned* st;
};

__device__ __forceinline__ XcdBarrier xcd_barrier_post(unsigned* bar, volatile LAS unsigned* st) {
    XcdBarrier b; b.bar = bar; b.x = xb_xcc_id(); b.st = st;
    if (threadIdx.x == 0) (void)xb_add(&bar[XB_XCNT(b.x)], 1u);
    return b;
}
__device__ __forceinline__ void xcd_barrier_complete(unsigned* bar, unsigned x, unsigned& nloc, unsigned& nx) {
    const unsigned G = gridDim.x * gridDim.y * gridDim.z;
    unsigned sum, cnt, mine, sp = 0u;
    for (;;) {
        sum = 0u; cnt = 0u; mine = 0u;
#pragma unroll
        for (unsigned j = 0; j < 16; ++j) { const unsigned c = xb_ld(&bar[XB_XCNT(j)]); sum += c; cnt += (c > 0u) ? 1u : 0u; mine = (j == x) ? c : mine; }
        if (sum == G) break;
        __builtin_amdgcn_s_sleep(1);
        if ((++sp & 255u) == 0u) { if (xb_ld(&bar[XB_TMO])) break; if (sp > XB_SPIN_CAP) { atomicAdd(&bar[XB_TMO], 1u); break; } }
    }
    nloc = mine > 0u ? mine : 1u; nx = cnt > 0u ? cnt : 1u;
}

__device__ __forceinline__ void xcd_barrier(const XcdBarrier& b) {
    asm volatile("s_waitcnt vmcnt(0)" ::: "memory");
    __syncthreads();
    if (threadIdx.x == 0) {
        unsigned* bar = b.bar;
        __builtin_amdgcn_s_waitcnt(0);
        unsigned nloc = b.st[0], nx = b.st[1];
        if (nloc == 0u) { xcd_barrier_complete(bar, b.x, nloc, nx); b.st[0] = nloc; b.st[1] = nx; }
        const unsigned old = xb_add(&bar[XB_XSUB(b.x)], 1u);
        const unsigned gen = old / nloc;
        if (old + 1u == (gen + 1u) * nloc) {
            __builtin_amdgcn_fence(__ATOMIC_RELEASE, "agent");
            asm volatile("s_waitcnt vmcnt(0)" ::: "memory");
            const unsigned og = xb_add(&bar[XB_TOP], 1u);
            const unsigned tg = og / nx;
            if (og + 1u == (tg + 1u) * nx) xb_add(&bar[XB_TOPGEN], 1u);
            else XB_SPIN(xb_ld(&bar[XB_TOPGEN]) == tg, bar);
            __builtin_amdgcn_fence(__ATOMIC_ACQUIRE, "agent");
            xb_add(&bar[XB_XGEN(b.x)], 1u);
            asm volatile("s_waitcnt vmcnt(0)" ::: "memory");
        } else {
            XB_SPIN(xb_ld(&bar[XB_XGEN(b.x)]) == gen, bar);
            __builtin_amdgcn_fence(__ATOMIC_ACQUIRE, "agent");
            asm volatile("s_waitcnt vmcnt(0)" ::: "memory");
        }
    }
    __syncthreads();
}
constexpr int NWAVES = 8;
#ifndef MK_N_LAUNCHES
#define MK_N_LAUNCHES 6
#endif
constexpr int N_LAUNCHES = MK_N_LAUNCHES;
constexpr int PER_PHASE = 6;
constexpr int BATCH = 4, T = 8192, D = 1024, M = BATCH * T;
constexpr int IN_W = 2208, NP1 = 2304;
constexpr float EPS = 1e-6f;
constexpr float C2_MLA = 0.14724444602590306f;
constexpr float C2_SWA = 0.18033688011112042f;

constexpr size_t MiB = 1u << 20;
constexpr size_t WS_CTL = 0, CTL_ZERO_BYTES = 1 * MiB;
constexpr size_t WS_WQ = 1 * MiB, WS_WKV = 1 * MiB + 512 * 1024, WS_WIN = 2 * MiB, WS_WOUT = 7 * MiB;
constexpr size_t WS_COS = 9 * MiB, WS_SIN = 11 * MiB, WS_PQ = 13 * MiB, WS_PKV = 13 * MiB + 512 * 1024;
constexpr size_t WS_QL = 16 * MiB, WS_KVL = 32 * MiB, WS_KS = 40 * MiB, WS_VS = 48 * MiB, WS_KPE = 56 * MiB;
constexpr size_t WS_QS = 64 * MiB, WS_G = 96 * MiB, WS_XN = 160 * MiB;
constexpr size_t WS_QN = 224 * MiB, WS_QPE = 256 * MiB, WS_KN = 272 * MiB, WS_V = 304 * MiB, WS_Y = 336 * MiB, WS_END = 400 * MiB;
constexpr int CW_TMO = 0, CW_CODE = 1, CW_BAR = 4096;

constexpr int RING_OFF = 0, RING_BYTES = 131072;
constexpr int LDSCTL_OFF = RING_BYTES, MISC_OFF = LDSCTL_OFF + 320;
constexpr int LDS_BYTES = 147456;
static_assert(att::A_END <= RING_BYTES, "attention scratch inside the ring region");

__device__ __forceinline__ float wave_sum(float v) {
#pragma unroll
    for (int o = 1; o < 64; o <<= 1) v += __shfl_xor(v, o);
    return v;
}
__device__ __forceinline__ void p0_transpose_item(const float* W, int N, int k0, int n0, const float* gain, bf16* WT, int K, int drow0, bool perm, LAS float* scr, int lane) {
#pragma unroll 8
    for (int i = 0; i < 32; ++i) { const int kk = 2 * i + (lane >> 5); const float g = gain ? gain[k0 + kk] : 1.0f; scr[kk * 33 + (lane & 31)] = W[(size_t)(k0 + kk) * N + n0 + (lane & 31)] * g; }
    LDS_WAIT(); asm volatile("" ::: "memory");
    const int c = lane & 7;
#pragma unroll
    for (int j = 0; j < 4; ++j) { const int n = (lane >> 3) + 8 * j; const LAS float* s = scr + (8 * c) * 33 + n;
        v4u o; o.x = pk2(s[0 * 33], s[1 * 33]); o.y = pk2(s[2 * 33], s[3 * 33]); o.z = pk2(s[4 * 33], s[5 * 33]); o.w = pk2(s[6 * 33], s[7 * 33]);
        const int dn = perm ? (8 * ((n & 15) >> 2) + 4 * (n >> 4) + (n & 3)) : n;
        *(GAS v4u*)(WT + (size_t)(drow0 + dn) * K + k0 + 8 * c) = o; }
    LDS_WAIT(); asm volatile("" ::: "memory");
}
__device__ __forceinline__ int win_dest_row(int n0) {
    if (n0 < 384) return n0;
    if (n0 < 416) return 640;
    if (n0 < 928) return 768 + (n0 - 416);
    if (n0 < 1056) return 384 + (n0 - 928);
    if (n0 < 1184) return 512 + (n0 - 1056);
    return 1280 + (n0 - 1184);
}
__constant__ float ROPE_INV[16] = {1.0f, 0.5623413251903491f, 0.31622776601683794f, 0.1778279410038923f, 0.1f, 0.05623413251903491f, 0.03162277660168379f, 0.01778279410038923f,
    0.01f, 0.005623413251903491f, 0.0031622776601683794f, 0.0017782794100389228f, 0.001f, 0.0005623413251903491f, 0.00031622776601683794f, 0.00017782794100389227f};

struct Args { const float* in[12]; const int* pos; float* out; unsigned char* ws; int ph_lo, ph_hi, li, pad; };

__global__ void __launch_bounds__(NWAVES * 64, 2) fwd_kernel(Args args) {
    extern __shared__ __attribute__((aligned(16))) unsigned char lds[];
    LAS unsigned char* L = (LAS unsigned char*)lds;
    volatile LAS unsigned* MISC = (volatile LAS unsigned*)(L + MISC_OFF);
    const int tid = threadIdx.x, lane = tid & 63, wave = __builtin_amdgcn_readfirstlane(tid >> 6);
    const int G = gridDim.x, bx = blockIdx.x, vcu = (G % 8 == 0) ? (bx % 8) * (G / 8) + bx / 8 : bx;
    unsigned char* ws = args.ws;
    gu32* ctl = (gu32*)(ws + WS_CTL);
    const float* x = args.in[0];
    bf16* Wq_t = (bf16*)(ws + WS_WQ); bf16* Wkv_t = (bf16*)(ws + WS_WKV); bf16* Win_t = (bf16*)(ws + WS_WIN); bf16* Wout_t = (bf16*)(ws + WS_WOUT);
    float* COS = (float*)(ws + WS_COS); float* SIN = (float*)(ws + WS_SIN); float* PQ = (float*)(ws + WS_PQ); float* PKV = (float*)(ws + WS_PKV);
    bf16 *QL = (bf16*)(ws + WS_QL), *KVL = (bf16*)(ws + WS_KVL), *KS = (bf16*)(ws + WS_KS), *VS = (bf16*)(ws + WS_VS), *KPE = (bf16*)(ws + WS_KPE);
    bf16 *QS = (bf16*)(ws + WS_QS), *GT = (bf16*)(ws + WS_G), *XN = (bf16*)(ws + WS_XN);
    bf16 *QN = (bf16*)(ws + WS_QN), *QPE = (bf16*)(ws + WS_QPE), *KN = (bf16*)(ws + WS_KN), *VV = (bf16*)(ws + WS_V), *Y = (bf16*)(ws + WS_Y);

    for (int u = tid; u < (LDS_BYTES - LDSCTL_OFF) / 4; u += NWAVES * 64) ((LAS unsigned*)(L + LDSCTL_OFF))[u] = 0u;
    __syncthreads();
    XcdBarrier bar; bar.bar = (unsigned*)(ctl + CW_BAR); bar.x = 0; bar.st = nullptr;
    if (N_LAUNCHES != PER_PHASE) bar = xcd_barrier_post((unsigned*)(ctl + CW_BAR), MISC + 8);
#define GRID_BAR(seam) do { if (N_LAUNCHES == PER_PHASE) { if (tid == 0) __hip_atomic_store(ctl + CW_TMO, 0xBADBA0u | (unsigned)(seam), RLX_AGENT); } else { xcd_barrier(bar); } } while (0)
    const int lo = args.ph_lo, hi = args.ph_hi;
#ifndef PH_MASK
#define PH_MASK 63
#endif
#define IN(k) (((PH_MASK >> (k)) & 1) && lo <= (k) && (k) < hi)
#define BOTH(k) (IN(k) && IN((k) + 1))

    if (IN(0)) {
        LAS float* scr = (LAS float*)(L + RING_OFF + wave * 16384);
        const int gw = vcu * NWAVES + wave, NGW = G * NWAVES;
        constexpr int I_IN = 16 * 69, I_Q = 4 * 24, I_KV = 2 * 32, I_OUT = 16 * 32, NITEMS = I_IN + I_Q + I_KV + I_OUT;
        for (int it = gw; it < NITEMS; it += NGW) {
            int r = it;
            if (r < I_IN) { const int kb = r / 69, cb = r % 69, n0 = 32 * cb; p0_transpose_item(args.in[3], IN_W, 64 * kb, n0, args.in[2], Win_t, 1024, win_dest_row(n0), cb == 12, scr, lane); continue; } r -= I_IN;
            if (r < I_Q) { const int kb = r / 24, cb = r % 24, h = cb / 3, part = cb % 3; p0_transpose_item(args.in[5], 768, 64 * kb, 32 * cb, args.in[4], Wq_t, 256, part < 2 ? h * 64 + part * 32 : 512 + h * 32, part == 2, scr, lane); continue; } r -= I_Q;
            if (r < I_KV) { const int kb = r / 32, cb = r % 32, h = cb / 4, part = cb % 4; p0_transpose_item(args.in[7], 1024, 64 * kb, 32 * cb, args.in[6], Wkv_t, 128, part < 2 ? h * 64 + part * 32 : 512 + h * 64 + (part - 2) * 32, false, scr, lane); continue; } r -= I_KV;
            { const int kb = r / 32, cb = r % 32; p0_transpose_item(args.in[10], 1024, 64 * kb, 32 * cb, nullptr, Wout_t, 1024, 32 * cb, false, scr, lane); }
        }
        { const int gt = vcu * (NWAVES * 64) + tid, NGT = G * NWAVES * 64; for (int i = gt; i < 96 * 1024 / 8; i += NGT) ((GAS v4u*)(Win_t + 672 * 1024))[i] = (v4u){0u, 0u, 0u, 0u};
          for (int e = gt; e < M * 16; e += NGT) { const int m = e >> 4, i = e & 15; const float a = (float)args.pos[m] * ROPE_INV[i];
              const double rev = (double)a * 0.15915494309189535; const float fr = (float)(rev - __builtin_rint(rev));
              COS[e] = __builtin_amdgcn_cosf(fr); SIN[e] = __builtin_amdgcn_sinf(fr); } }
        for (int m = gw; m < M; m += NGW) {
            const GAS f32x4* xr = (const GAS f32x4*)(x + (size_t)m * D) + lane; f32x4 v[4]; float s = 0.f;
#pragma unroll
            for (int j = 0; j < 4; ++j) { v[j] = xr[64 * j]; s += (v[j].x * v[j].x + v[j].y * v[j].y) + (v[j].z * v[j].z + v[j].w * v[j].w); }
            const float rstd = 1.0f / sqrtf(wave_sum(s) * (1.0f / D) + EPS);
            GAS unsigned long long* o8 = (GAS unsigned long long*)(XN + (size_t)m * D) + lane;
#pragma unroll
            for (int j = 0; j < 4; ++j) o8[64 * j] = (unsigned long long)pk2(v[j].x * rstd, v[j].y * rstd) | ((unsigned long long)pk2(v[j].z * rstd, v[j].w * rstd) << 32);
        }
        if (BOTH(0)) GRID_BAR(0);
    }
    if (IN(1)) {
        pg8::Gemm g{XN, Win_t, M, NP1, D}; pg8::StaticOrder S; S.init(M, NP1, G, bx);
        pg8::EpiProj E{QL, KVL, KS, VS, KPE, QS, GT, PQ, PKV, COS, SIN, C2_SWA};
        pg8::gemm_phase<pg8::EpiProj, pg8::StaticOrder, PG8_ALIGN, PG8_SP2>(L + RING_OFF, g, S, E);
        if (BOTH(1)) GRID_BAR(1);
    }
    if (IN(2)) {
#pragma clang loop unroll(disable)
        for (int gi = 0; gi < 2; ++gi) {
            const pg8::Gemm g = (gi == 0) ? pg8::Gemm{QL, Wq_t, M, 768, 256} : pg8::Gemm{KVL, Wkv_t, M, 1024, 128};
            const pg8::EpiRS E = (gi == 0) ? pg8::EpiRS{QN, QPE, 256, PQ, 1.0f / 256.0f, C2_MLA, EPS} : pg8::EpiRS{KN, VV, 512, PKV, 1.0f / 128.0f, 1.0f, EPS};
            pg8::StaticOrder S; S.init(M, g.N, G, bx);
            pg8::gemm_phase<pg8::EpiRS, pg8::StaticOrder, PG8_ALIGN, PG8_SP2>(L + RING_OFF, g, S, E);
        }
        if (BOTH(2)) GRID_BAR(2);
    }
    if (IN(3)) {
        att::AttnPtrs P{QN, QPE, KN, KPE, VV, QS, KS, VS, GT, Y, args.pos, args.in[8], args.in[9], COS, SIN};
        ALDS char* shm = (ALDS char*)(L + RING_OFF);
        if (G == 256) {
            const int bh = vcu >> 3, s = vcu & 7;
            for (int i = 0; i < 4; ++i) { const int qb = (i == 0) ? s : (i == 1) ? 15 - s : (i == 2) ? 16 + s : 31 - s; att::mla_unit(bh >> 3, bh & 7, qb, P, shm); }
        } else {
            for (int u = bx; u < 1024; u += G) att::mla_unit(u >> 8, (u >> 5) & 7, u & 31, P, shm);
        }
        for (int u = bx; u < 512; u += G) att::swa_unit(u >> 7, (u >> 6) & 1, u & 63, P, shm);
        if (BOTH(3)) GRID_BAR(3);
    }
    if (IN(4)) {
        pg8::Gemm g{Y, Wout_t, M, D, D}; pg8::StaticOrder S; S.init(M, D, G, bx);
        pg8::EpiOut E{x, args.out};
        pg8::gemm_phase<pg8::EpiOut, pg8::StaticOrder, PG8_ALIGN, PG8_SP2>(L + RING_OFF, g, S, E);
        if (BOTH(4)) GRID_BAR(4);
    }
    if (IN(5)) {
        const int gw = vcu * NWAVES + wave, NGW = G * NWAVES; const float* fn = args.in[11];
        f32x4 gv[4];
#pragma unroll
        for (int j = 0; j < 4; ++j) gv[j] = ((const GAS f32x4*)fn)[lane + 64 * j];
        for (int m = gw; m < M; m += NGW) {
            GAS f32x4* xr = (GAS f32x4*)(args.out + (size_t)m * D) + lane; f32x4 v[4]; float s = 0.f;
#pragma unroll
            for (int j = 0; j < 4; ++j) { v[j] = xr[64 * j]; s += (v[j].x * v[j].x + v[j].y * v[j].y) + (v[j].z * v[j].z + v[j].w * v[j].w); }
            const float rstd = 1.0f / sqrtf(wave_sum(s) * (1.0f / D) + EPS);
#pragma unroll
            for (int j = 0; j < 4; ++j) xr[64 * j] = v[j] * rstd * gv[j];
        }
    }
#undef IN
#undef BOTH
}

extern "C" void kernel_launch(void* const* d_in, const int* in_sizes, int n_in, void* d_out, int out_size, void* d_ws, size_t ws_size, hipStream_t stream) {
    static int grid = 0;
    if (grid == 0) {
        if (n_in != 12 || in_sizes[0] != M * D || out_size != M * D || ws_size < WS_END) { fprintf(stderr, "kernel_launch: unexpected shapes (n_in %d, in0 %d, out %d, ws %zu)\n", n_in, n_in > 0 ? in_sizes[0] : -1, out_size, ws_size); grid = -1; return; }
        int dev = 0, cus = 0;
        if (hipGetDevice(&dev) != hipSuccess || hipDeviceGetAttribute(&cus, hipDeviceAttributeMultiprocessorCount, dev) != hipSuccess) { grid = -1; return; }
        if (hipFuncSetAttribute((const void*)fwd_kernel, hipFuncAttributeMaxDynamicSharedMemorySize, LDS_BYTES) != hipSuccess) { fprintf(stderr, "kernel_launch: hipFuncSetAttribute failed\n"); grid = -1; return; }
        int per_cu = 0;
        if (hipOccupancyMaxActiveBlocksPerMultiprocessor(&per_cu, (const void*)fwd_kernel, NWAVES * 64, LDS_BYTES) != hipSuccess || per_cu < 1) fprintf(stderr, "kernel_launch: occupancy query says %d\n", per_cu);
        (void)hipGetLastError();
        grid = cus;
    }
    if (grid < 0) return;
    (void)hipMemsetAsync((char*)d_ws + WS_CTL, 0, CTL_ZERO_BYTES, stream);
    Args a{};
    for (int i = 0; i < 12; ++i) a.in[i] = (const float*)d_in[i];
    a.pos = (const int*)d_in[1]; a.out = (float*)d_out; a.ws = (unsigned char*)d_ws;
    if (N_LAUNCHES == 1) { a.ph_lo = 0; a.ph_hi = PER_PHASE; a.li = 0; hipLaunchKernelGGL(fwd_kernel, dim3(grid), dim3(NWAVES * 64), LDS_BYTES, stream, a); }
    else for (int li = 0; li < PER_PHASE; ++li) { a.ph_lo = li; a.ph_hi = li + 1; a.li = li; hipLaunchKernelGGL(fwd_kernel, dim3(grid), dim3(NWAVES * 64), LDS_BYTES, stream, a); }
}
```

```cpp
#include <hip/hip_runtime.h>
#include <hip/hip_bf16.h>
#include <cstdio>
#include <cstdint>
#include <cmath>
namespace pg8 {
#define PG8_LAS __attribute__((address_space(3)))
typedef unsigned short bf16_t;
typedef short bf16x8 __attribute__((ext_vector_type(8)));
typedef float f32x4 __attribute__((ext_vector_type(4)));
typedef unsigned u32x4 __attribute__((ext_vector_type(4)));
constexpr int BM = 256, BK = 64, HALF = 128, HTB = HALF * BK * 2  , STAGE_BYTES = 8 * HTB, NXCD = 8, WGM = 8;

__host__ __device__ __forceinline__ int lds_byte(int r, int c) { const int st = (r >> 4) * 2 + (c >> 5), rr = r & 15, cc = c & 31, ob = rr * 64 + cc * 2; return st * 1024 + (ob ^ (((ob >> 9) & 1) << 5)); }
__host__ __device__ __forceinline__ void stage_rc(int b, int& R, int& C) { const int st = b / 1024, sb = b % 1024, swz = sb ^ (((sb >> 9) & 1) << 5); R = (st >> 1) * 16 + swz / 64; C = (st & 1) * 32 + (swz % 64) / 2; }
__host__ __device__ __forceinline__ int perm32(int rho) { const int n = rho >> 4, i = rho & 15; return 8 * (i >> 2) + 4 * n + (i & 3); }

struct Unit { int pm, pn; };
struct Gemm { const bf16_t* A; const bf16_t* Bt; int M, N, K; };

struct StaticOrder {
    int nM, nN, nwg, G, c;
    __host__ __device__ void init(int M, int N, int G_, int c_) { nM = M / BM; nN = N / BM; nwg = nM * nN; G = G_; c = c_; }
    __host__ __device__ bool next(int i, Unit& u) const {
        const long L = (long)i * G + c; if (L >= nwg) return false;
        int wgid = (int)L; { const int q = nwg / NXCD, r = nwg % NXCD, xcd = wgid % NXCD, off = wgid / NXCD; wgid = (xcd < r ? xcd * (q + 1) : r * (q + 1) + (xcd - r) * q) + off; }
        const int nig = WGM * nN, gid = wgid / nig, fm = gid * WGM, gsz = (nM - fm) < WGM ? (nM - fm) : WGM;
        u.pm = fm + ((wgid % nig) % gsz); u.pn = (wgid % nig) / gsz; return true;
    }
    __device__ __forceinline__ void a_ready(const Unit&) const {}
    __device__ __forceinline__ void done(const Unit&) const {}
};

__device__ __forceinline__ unsigned cvt_pk_bf16(float lo, float hi) { unsigned r; asm volatile("v_cvt_pk_bf16_f32 %0, %1, %2" : "=v"(r) : "v"(lo), "v"(hi)); return r; }
typedef float f32x2 __attribute__((ext_vector_type(2)));
typedef float f32x2 __attribute__((ext_vector_type(2)));
typedef unsigned u32x2 __attribute__((ext_vector_type(2)));
__device__ __forceinline__ u32x4 pack8(f32x4 v0, f32x4 v1) { u32x4 w; w.x = cvt_pk_bf16(v0[0], v0[1]); w.y = cvt_pk_bf16(v0[2], v0[3]); w.z = cvt_pk_bf16(v1[0], v1[1]); w.w = cvt_pk_bf16(v1[2], v1[3]); return w; }
__device__ __forceinline__ float silu_f(float v) { return v * __builtin_amdgcn_rcpf(1.0f + __builtin_amdgcn_exp2f(-1.4426950408889634f * v)); }
__device__ __forceinline__ float sq4(f32x4 v) { return (v[0] * v[0] + v[1] * v[1]) + (v[2] * v[2] + v[3] * v[3]); }

struct EpiProj {
    static constexpr bool PERM = true, AFTER_DRAIN = false;
    bf16_t *QL, *KVL, *KS, *VS, *KPE, *QS, *G; float *PQ, *PKV; const float *COS, *SIN; float qs_scale;
    __device__ __forceinline__ void operator()(const f32x4 (&acc)[2][2][4][2], const Unit& u, int wr, int wc, int fr, int fq) const {
        const int row0 = u.pm * BM + wr * 64 + fr, pn = u.pn, cw = wc * 32 + 8 * fq;
        if (pn == 0) {
#pragma unroll
            for (int ai = 0; ai < 2; ++ai)
#pragma unroll
                for (int m = 0; m < 4; ++m) { const size_t row = (size_t)(row0 + ai * HALF + m * 16); float s = 0.f;
#pragma unroll
                    for (int bj = 0; bj < 2; ++bj) { s += sq4(acc[ai][bj][m][0]) + sq4(acc[ai][bj][m][1]); *(u32x4*)(QL + row * 256 + bj * HALF + cw) = pack8(acc[ai][bj][m][0], acc[ai][bj][m][1]); }
                    s += __shfl_xor(s, 16); s += __shfl_xor(s, 32);
                    if (fq == 0) PQ[row * 4 + wc] = s; }
        } else if (pn == 1) {
#pragma unroll
            for (int ai = 0; ai < 2; ++ai)
#pragma unroll
                for (int m = 0; m < 4; ++m) { const size_t row = (size_t)(row0 + ai * HALF + m * 16);
                    float s = sq4(acc[ai][0][m][0]) + sq4(acc[ai][0][m][1]);
                    *(u32x4*)(KVL + row * 128 + cw) = pack8(acc[ai][0][m][0], acc[ai][0][m][1]);
                    *(u32x4*)(KS + row * 128 + cw) = pack8(acc[ai][1][m][0], acc[ai][1][m][1]);
                    s += __shfl_xor(s, 16); s += __shfl_xor(s, 32);
                    if (fq == 0) PKV[row * 4 + wc] = s; }
        } else if (pn == 2) {
#pragma unroll
            for (int ai = 0; ai < 2; ++ai)
#pragma unroll
                for (int m = 0; m < 4; ++m) { const size_t row = (size_t)(row0 + ai * HALF + m * 16);
                    *(u32x4*)(VS + row * 128 + cw) = pack8(acc[ai][0][m][0], acc[ai][0][m][1]);
                    if (wc == 0) { const f32x4 c = *(const f32x4*)(COS + row * 16 + 4 * fq), s = *(const f32x4*)(SIN + row * 16 + 4 * fq);
                        const f32x4 x1 = acc[ai][1][m][0], x2 = acc[ai][1][m][1];
                        *(u32x4*)(KPE + row * 32 + 8 * fq) = pack8(x1 * c - x2 * s, x2 * c + x1 * s); }
                    asm volatile("" ::: "memory"); }
        } else if (pn < 5) {
            const int c0 = (pn - 3) * 256 + cw;
#pragma unroll
            for (int ai = 0; ai < 2; ++ai)
#pragma unroll
                for (int m = 0; m < 4; ++m) { const size_t row = (size_t)(row0 + ai * HALF + m * 16);
#pragma unroll
                    for (int bj = 0; bj < 2; ++bj) *(u32x4*)(QS + row * 512 + c0 + bj * HALF) = pack8(acc[ai][bj][m][0] * qs_scale, acc[ai][bj][m][1] * qs_scale); }
        } else {
            const int c0 = (pn - 5) * 256 + cw;
#pragma unroll
            for (int ai = 0; ai < 2; ++ai)
#pragma unroll
                for (int m = 0; m < 4; ++m) { const size_t row = (size_t)(row0 + ai * HALF + m * 16);
#pragma unroll
                    for (int bj = 0; bj < 2; ++bj) { f32x4 a = acc[ai][bj][m][0], b = acc[ai][bj][m][1];
#pragma unroll
                        for (int j = 0; j < 4; ++j) { a[j] = silu_f(a[j]); b[j] = silu_f(b[j]); }
                        *(u32x4*)(G + row * 1024 + c0 + bj * HALF) = pack8(a, b); } }
        }
    }
};
struct EpiRS {
    static constexpr bool PERM = true, AFTER_DRAIN = false;
    bf16_t *D0, *D1; int p1; const float* PP; float inv_n, scale, eps;
    __device__ __forceinline__ void operator()(const f32x4 (&acc)[2][2][4][2], const Unit& u, int wr, int wc, int fr, int fq) const {
        const int row0 = u.pm * BM + wr * 64 + fr, pn = u.pn, cw = wc * 32 + 8 * fq;
        bf16_t* dst = (pn < 2) ? D0 : D1; const int pitch = (pn < 2) ? 512 : p1, c0 = (pn & 1) * 256 + cw;
#pragma unroll
        for (int ai = 0; ai < 2; ++ai)
#pragma unroll
            for (int m = 0; m < 4; ++m) { const size_t row = (size_t)(row0 + ai * HALF + m * 16);
                const f32x4 pq = *(const f32x4*)(PP + row * 4);
                const float rs = __builtin_amdgcn_rsqf(((pq[0] + pq[1]) + (pq[2] + pq[3])) * inv_n + eps) * scale;
#pragma unroll
                for (int bj = 0; bj < 2; ++bj) *(u32x4*)(dst + row * pitch + c0 + bj * HALF) = pack8(acc[ai][bj][m][0] * rs, acc[ai][bj][m][1] * rs);
                asm volatile("" ::: "memory"); }
    }
};
struct EpiOut {
    static constexpr bool PERM = false, AFTER_DRAIN = false;
    const float* X; float* O;
    __device__ __forceinline__ void operator()(const f32x4 (&acc)[2][2][4][2], const Unit& u, int wr, int wc, int fr, int fq) const {
        const int row0 = u.pm * BM + wr * 64 + fr, col0 = u.pn * BM + wc * 32 + 4 * fq;
#pragma unroll
        for (int ai = 0; ai < 2; ++ai)
#pragma unroll
            for (int m = 0; m < 4; ++m) { const size_t off = (size_t)(row0 + ai * HALF + m * 16) * 1024 + col0;
#pragma unroll
                for (int bj = 0; bj < 2; ++bj)
#pragma unroll
                    for (int n = 0; n < 2; ++n) { const f32x4 xv = *(const f32x4*)(X + off + bj * HALF + n * 16); *(f32x4*)(O + off + bj * HALF + n * 16) = xv + acc[ai][bj][m][n]; }
                if (m & 1) asm volatile("" ::: "memory"); }
    }
};
template <class Epi, class Sched, bool ALIGN_EPI = false, bool SP2 = false>
__device__ __forceinline__ void gemm_phase(PG8_LAS unsigned char* lds, const Gemm g, const Sched& S, const Epi& E) {
    const int tid = threadIdx.x, wid = __builtin_amdgcn_readfirstlane(tid >> 6), lane = tid & 63, wr = wid >> 2, wc = wid & 3, fr = lane & 15, fq = lane >> 4;
    const int K = g.K, nt = K / BK;
    unsigned voffA[2], voffB[2];
#pragma unroll
    for (int i = 0; i < 2; ++i) { int R, C; stage_rc(tid * 16 + i * 8192, R, C); const int Rb = Epi::PERM ? ((R & ~31) + perm32(R & 31)) : R;
        voffA[i] = (unsigned)(R * K + C) * 2u; voffB[i] = (unsigned)(Rb * K + C) * 2u; }
    const size_t kstep = (size_t)(BK * 2);
    const size_t hstep = (size_t)HALF * K * 2;
    const size_t tstep = 2 * hstep;
    const unsigned ldsw = (unsigned)wid * 1024u;
    const int aoff = lds_byte(wr * 64 + fr, fq * 8), boff = lds_byte(wc * 32 + fr, fq * 8);
#define PG8_SA(b, h) (((b) * 2 + (h)) * HTB)
#define PG8_SB(b, h) ((4 + (b) * 2 + (h)) * HTB)
#define PG8_STAGE(bufoff, gbase, voff) do { _Pragma("unroll") for (int _i = 0; _i < 2; ++_i) \
        __builtin_amdgcn_global_load_lds((const unsigned*)((const char*)(gbase) + (voff)[_i]), (PG8_LAS unsigned*)(lds + (bufoff) + ldsw + _i * 8192), 16, 0, 0); } while (0)
#define PG8_LDA(dst, b, h) do { _Pragma("unroll") for (int m = 0; m < 4; ++m) _Pragma("unroll") for (int k = 0; k < 2; ++k) dst[m][k] = *(const PG8_LAS bf16x8*)(lds + PG8_SA(b, h) + aoff + m * 2048 + k * 1024); } while (0)
#define PG8_LDB(dst, b, h) do { _Pragma("unroll") for (int n = 0; n < 2; ++n) _Pragma("unroll") for (int k = 0; k < 2; ++k) dst[n][k] = *(const PG8_LAS bf16x8*)(lds + PG8_SB(b, h) + boff + n * 2048 + k * 1024); } while (0)
#define PG8_MMA(ai, bj, At, Bt) do { __builtin_amdgcn_s_setprio(1); _Pragma("unroll") for (int m = 0; m < 4; ++m) _Pragma("unroll") for (int n = 0; n < 2; ++n) _Pragma("unroll") for (int k = 0; k < 2; ++k) \
        acc[ai][bj][m][n] = __builtin_amdgcn_mfma_f32_16x16x32_bf16(Bt[n][k], At[m][k], acc[ai][bj][m][n], 0, 0, 0); __builtin_amdgcn_s_setprio(0); } while (0)
#define PG8_WAIT_V(n) asm volatile("s_waitcnt vmcnt(" #n ")" ::: "memory")
#define PG8_WAIT_L(n) asm volatile("s_waitcnt lgkmcnt(" #n ")" ::: "memory")
#define PG8_BAR __builtin_amdgcn_s_barrier()
#define PG8_SCHED __builtin_amdgcn_sched_barrier(0)
    Unit cur, nxt; int ui = 0;
    if (!S.next(0, cur)) return;
    f32x4 acc[2][2][4][2];
#pragma unroll
    for (int a = 0; a < 2; ++a)
#pragma unroll
        for (int b = 0; b < 2; ++b)
#pragma unroll
            for (int m = 0; m < 4; ++m)
#pragma unroll
                for (int n = 0; n < 2; ++n) acc[a][b][m][n] = (f32x4){0.f, 0.f, 0.f, 0.f};
    bf16x8 At[4][2], B0[2][2], B1[2][2];
    const char* cA = (const char*)g.A + (size_t)cur.pm * tstep; const char* cB = (const char*)g.Bt + (size_t)cur.pn * tstep;
    S.a_ready(cur);
    if constexpr (SP2) {
        PG8_STAGE(PG8_SB(0, 0), cB, voffB); PG8_STAGE(PG8_SB(0, 1), cB + hstep, voffB); PG8_STAGE(PG8_SA(0, 0), cA, voffA); PG8_STAGE(PG8_SA(0, 1), cA + hstep, voffA);
        if (wr == 1) PG8_BAR;
        PG8_WAIT_V(2); PG8_BAR;
        PG8_STAGE(PG8_SB(1, 0), cB + kstep, voffB); PG8_STAGE(PG8_SA(1, 0), cA + kstep, voffA); PG8_STAGE(PG8_SB(1, 1), cB + hstep + kstep, voffB);
        PG8_WAIT_V(6); PG8_BAR;
    } else {
        PG8_STAGE(PG8_SB(0, 0), cB, voffB); PG8_STAGE(PG8_SA(0, 0), cA, voffA); PG8_STAGE(PG8_SB(0, 1), cB + hstep, voffB); PG8_STAGE(PG8_SA(0, 1), cA + hstep, voffA);
        if (wr == 1) PG8_BAR;
        PG8_WAIT_V(4); PG8_BAR;
        PG8_STAGE(PG8_SB(1, 0), cB + kstep, voffB); PG8_STAGE(PG8_SA(1, 0), cA + kstep, voffA); PG8_STAGE(PG8_SB(1, 1), cB + hstep + kstep, voffB);
        PG8_WAIT_V(6); PG8_BAR;
    }
    for (;;) {
        const bool has_next = S.next(ui + 1, nxt);
        const char* nA = has_next ? (const char*)g.A + (size_t)nxt.pm * tstep : cA; const char* nB = has_next ? (const char*)g.Bt + (size_t)nxt.pn * tstep : cB;
        for (int t = 0; t < nt; t += 2) {
            const bool last = (t == nt - 2);
            const char* a1 = cA + (size_t)(t + 1) * kstep;
            const char* a2 = last ? nA : cA + (size_t)(t + 2) * kstep; const char* b2 = last ? nB : cB + (size_t)(t + 2) * kstep;
            const char* a3 = a2 + kstep; const char* b3 = b2 + kstep;
            if (last && has_next) S.a_ready(nxt);
            if constexpr (SP2) {
            PG8_LDB(B0, 0, 0); PG8_LDB(B1, 0, 1); PG8_SCHED; PG8_LDA(At, 0, 0); PG8_STAGE(PG8_SA(1, 1), a1 + hstep, voffA);
            PG8_WAIT_V(8); PG8_WAIT_L(0); PG8_BAR; PG8_MMA(0, 0, At, B0); PG8_MMA(0, 1, At, B1); PG8_BAR; PG8_SCHED;
            PG8_LDA(At, 0, 1); PG8_STAGE(PG8_SB(0, 0), b2, voffB); PG8_STAGE(PG8_SB(0, 1), b2 + hstep, voffB); PG8_STAGE(PG8_SA(0, 0), a2, voffA);
            PG8_WAIT_V(8); PG8_WAIT_L(0); PG8_BAR; PG8_MMA(1, 0, At, B0); PG8_MMA(1, 1, At, B1); PG8_BAR; PG8_SCHED;
            PG8_LDB(B0, 1, 0); PG8_LDB(B1, 1, 1); PG8_SCHED; PG8_LDA(At, 1, 0); PG8_STAGE(PG8_SA(0, 1), a2 + hstep, voffA);
            PG8_WAIT_V(8); PG8_WAIT_L(0); PG8_BAR; PG8_MMA(0, 0, At, B0); PG8_MMA(0, 1, At, B1); PG8_BAR; PG8_SCHED;
            PG8_LDA(At, 1, 1); PG8_STAGE(PG8_SB(1, 0), b3, voffB); PG8_STAGE(PG8_SB(1, 1), b3 + hstep, voffB); PG8_STAGE(PG8_SA(1, 0), a3, voffA);
            PG8_WAIT_V(8); PG8_WAIT_L(0); PG8_BAR; PG8_MMA(1, 0, At, B0); PG8_MMA(1, 1, At, B1); PG8_BAR; PG8_SCHED;
            } else {
            PG8_LDB(B0, 0, 0); PG8_SCHED; PG8_LDA(At, 0, 0); PG8_STAGE(PG8_SA(1, 1), a1 + hstep, voffA);
            PG8_WAIT_L(8); PG8_BAR; PG8_WAIT_L(0); PG8_MMA(0, 0, At, B0); PG8_BAR; PG8_SCHED;
            PG8_LDB(B1, 0, 1); PG8_STAGE(PG8_SB(0, 0), b2, voffB);
            PG8_BAR; PG8_WAIT_L(0); PG8_MMA(0, 1, At, B1); PG8_BAR;
            PG8_LDA(At, 0, 1); PG8_STAGE(PG8_SA(0, 0), a2, voffA);
            PG8_BAR; PG8_WAIT_L(0); PG8_MMA(1, 0, At, B0); PG8_BAR; PG8_SCHED;
            PG8_STAGE(PG8_SB(0, 1), b2 + hstep, voffB);
            PG8_WAIT_V(6); PG8_BAR; PG8_MMA(1, 1, At, B1); PG8_BAR;
            PG8_LDB(B0, 1, 0); PG8_SCHED; PG8_LDA(At, 1, 0); PG8_STAGE(PG8_SA(0, 1), a2 + hstep, voffA);
            PG8_WAIT_L(8); PG8_BAR; PG8_WAIT_L(0); PG8_MMA(0, 0, At, B0); PG8_BAR; PG8_SCHED;
            PG8_LDB(B1, 1, 1); PG8_STAGE(PG8_SB(1, 0), b3, voffB);
            PG8_BAR; PG8_WAIT_L(0); PG8_MMA(0, 1, At, B1); PG8_BAR;
            PG8_LDA(At, 1, 1); PG8_STAGE(PG8_SA(1, 0), a3, voffA);
            PG8_BAR; PG8_WAIT_L(0); PG8_MMA(1, 0, At, B0); PG8_BAR; PG8_SCHED;
            PG8_STAGE(PG8_SB(1, 1), b3 + hstep, voffB);
            PG8_WAIT_V(6); PG8_BAR; PG8_MMA(1, 1, At, B1); PG8_BAR;
            }
        }
        if constexpr (ALIGN_EPI) { if (wr == 0) PG8_BAR; }
        if constexpr (!Epi::AFTER_DRAIN) { E(acc, cur, wr, wc, fr, fq); S.done(cur); }
        if (!has_next) break;
#pragma unroll
        for (int a = 0; a < 2; ++a)
#pragma unroll
            for (int b = 0; b < 2; ++b)
#pragma unroll
                for (int m = 0; m < 4; ++m)
#pragma unroll
                    for (int n = 0; n < 2; ++n) acc[a][b][m][n] = (f32x4){0.f, 0.f, 0.f, 0.f};
        cur = nxt; cA = nA; cB = nB; ++ui;
        if constexpr (ALIGN_EPI) { if (wr == 1) PG8_BAR; }
    }
    PG8_WAIT_V(0);
    if constexpr (!ALIGN_EPI) { if (wr == 0) PG8_BAR; }
    PG8_BAR;
    if constexpr (Epi::AFTER_DRAIN) { E.fused(acc, cur, wr, wc, fr, fq, lds, wid, lane); S.done(cur); }
#undef PG8_SA
#undef PG8_SB
#undef PG8_STAGE
#undef PG8_LDA
#undef PG8_LDB
#undef PG8_MMA
#undef PG8_WAIT_V
#undef PG8_WAIT_L
#undef PG8_BAR
#undef PG8_SCHED
}
}
#ifndef PG8_SP2
#define PG8_SP2 true
#endif
#ifndef PG8_ALIGN
#define PG8_ALIGN true
#endif
namespace att {
using bf16x8 = __attribute__((ext_vector_type(8))) short;
using s16x4 = __attribute__((ext_vector_type(4))) short;
using f32x16 = __attribute__((ext_vector_type(16))) float;
using u32x4 = __attribute__((ext_vector_type(4))) unsigned;
using f32x4 = __attribute__((ext_vector_type(4))) float;
typedef unsigned short bf16_t;
#define ALDS __attribute__((address_space(3)))
#define SBAR() __builtin_amdgcn_sched_barrier(0)
constexpr int SEQ = 8192, NBATCH = 4;
constexpr float LOG2E = 1.4426950408889634f;
__device__ __forceinline__ int crow(int r, int hi) { return (r & 3) + 8 * (r >> 2) + 4 * hi; }
typedef float f32x2_t __attribute__((ext_vector_type(2))); typedef __bf16 bf16x2_t __attribute__((ext_vector_type(2)));
__device__ __forceinline__ unsigned cvtpk_s(float lo, float hi) { f32x2_t v = {lo, hi}; bf16x2_t b = __builtin_convertvector(v, bf16x2_t); return __builtin_bit_cast(unsigned, b); }
__device__ __forceinline__ float bf_lo(unsigned w) { return __uint_as_float(w << 16); }
__device__ __forceinline__ float bf_hi(unsigned w) { return __uint_as_float(w & 0xffff0000u); }
#define MX3(a, b, c) __builtin_fmaxf(__builtin_fmaxf((a), (b)), (c))
__device__ __forceinline__ float rowmax(const f32x16& p0, const f32x16& p1) {
    float a = MX3(p0[0], p0[1], p1[0]), b = MX3(p0[2], p0[3], p1[1]); a = MX3(a, p1[2], p1[3]);
#pragma unroll
    for (int r = 4; r < 16; r += 4) { a = MX3(a, p0[r], p0[r + 1]); b = MX3(b, p0[r + 2], p0[r + 3]); a = MX3(a, p1[r], p1[r + 1]); b = MX3(b, p1[r + 2], p1[r + 3]); }
    float m = __builtin_fmaxf(a, b); auto rr = __builtin_amdgcn_permlane32_swap(__float_as_uint(m), __float_as_uint(m), false, false);
    return __builtin_fmaxf(__uint_as_float(rr[0]), __uint_as_float(rr[1])); }
template <int NDS> __device__ __forceinline__ void qkt(f32x16& p0, f32x16& p1, const ALDS char* Kslot, const bf16x8* qr, int r32, int hi) {
    const ALDS char* kb = Kslot + hi * 1024 + r32 * 16;
    p0 = f32x16{}; p1 = f32x16{};
#pragma unroll
    for (int d0 = 0; d0 < NDS; ++d0) {
        const bf16x8 b0 = *(const ALDS bf16x8*)(kb + d0 * 2048), b1 = *(const ALDS bf16x8*)(kb + d0 * 2048 + 512);
        p0 = __builtin_amdgcn_mfma_f32_32x32x16_bf16(b0, qr[d0], p0, 0, 0, 0); p1 = __builtin_amdgcn_mfma_f32_32x32x16_bf16(b1, qr[d0], p1, 0, 0, 0); }
}
__device__ __forceinline__ void pv(f32x16* o, int vb, bf16x8 pa0, bf16x8 pa1, bf16x8 pa2, bf16x8 pa3) {
#pragma unroll
    for (int d0 = 0; d0 < 2; ++d0) { s16x4 lo[4], hi[4];
#pragma unroll
        for (int ks = 0; ks < 4; ++ks) {
            asm volatile("ds_read_b64_tr_b16 %0,%1 offset:%c2" : "=&v"(lo[ks]) : "v"(vb), "i"(d0 * 4096 + ks * 1024) : "memory");
            asm volatile("ds_read_b64_tr_b16 %0,%1 offset:%c2" : "=&v"(hi[ks]) : "v"(vb), "i"(d0 * 4096 + ks * 1024 + 512) : "memory"); }
        asm volatile("s_waitcnt lgkmcnt(0)" ::: "memory"); SBAR();
#define PK(k) (bf16x8){lo[k][0], lo[k][1], lo[k][2], lo[k][3], hi[k][0], hi[k][1], hi[k][2], hi[k][3]}
        o[d0] = __builtin_amdgcn_mfma_f32_32x32x16_bf16(pa0, PK(0), o[d0], 0, 0, 0);
        o[d0] = __builtin_amdgcn_mfma_f32_32x32x16_bf16(pa1, PK(1), o[d0], 0, 0, 0);
        o[d0] = __builtin_amdgcn_mfma_f32_32x32x16_bf16(pa2, PK(2), o[d0], 0, 0, 0);
        o[d0] = __builtin_amdgcn_mfma_f32_32x32x16_bf16(pa3, PK(3), o[d0], 0, 0, 0);
#undef PK
    }
}
__device__ __forceinline__ void softmax_pv(f32x16& p0, f32x16& p1, float& m, float& l, f32x16* o, ALDS float* wsf, int vb, int r32, int hi) {
    const float rm = rowmax(p0, p1), mn = __builtin_fmaxf(m, rm), alpha = __builtin_amdgcn_exp2f(m - mn); m = mn;
    float ls = 0.f;
#pragma unroll
    for (int r = 0; r < 16; ++r) { p0[r] = __builtin_amdgcn_exp2f(p0[r] - mn); p1[r] = __builtin_amdgcn_exp2f(p1[r] - mn); ls += p0[r] + p1[r]; }
    l = l * alpha + ls;
    if (hi == 0) wsf[r32] = alpha;
    asm volatile("s_waitcnt lgkmcnt(0)" ::: "memory");
#pragma unroll
    for (int d = 0; d < 2; ++d)
#pragma unroll
        for (int r = 0; r < 16; ++r) o[d][r] *= wsf[crow(r, hi)];
    u32x4 pw0 = {cvtpk_s(p0[0], p0[1]), cvtpk_s(p0[2], p0[3]), cvtpk_s(p0[4], p0[5]), cvtpk_s(p0[6], p0[7])};
    u32x4 pw1 = {cvtpk_s(p0[8], p0[9]), cvtpk_s(p0[10], p0[11]), cvtpk_s(p0[12], p0[13]), cvtpk_s(p0[14], p0[15])};
    u32x4 pw2 = {cvtpk_s(p1[0], p1[1]), cvtpk_s(p1[2], p1[3]), cvtpk_s(p1[4], p1[5]), cvtpk_s(p1[6], p1[7])};
    u32x4 pw3 = {cvtpk_s(p1[8], p1[9]), cvtpk_s(p1[10], p1[11]), cvtpk_s(p1[12], p1[13]), cvtpk_s(p1[14], p1[15])};
    asm volatile("s_waitcnt lgkmcnt(0)" ::: "memory"); SBAR();
    pv(o, vb, __builtin_bit_cast(bf16x8, pw0), __builtin_bit_cast(bf16x8, pw1), __builtin_bit_cast(bf16x8, pw2), __builtin_bit_cast(bf16x8, pw3));
}
__device__ __forceinline__ void attn_epilogue(const f32x16* o, float l, ALDS float* wsf, ALDS bf16_t* stg, const bf16_t* G, bf16_t* Y, size_t grow, int ycol, int lane, int r32, int hi) {
    { auto rr = __builtin_amdgcn_permlane32_swap(__float_as_uint(l), __float_as_uint(l), false, false); l = __uint_as_float(rr[0]) + __uint_as_float(rr[1]); }
    if (hi == 0) wsf[32 + r32] = l;
    asm volatile("s_waitcnt lgkmcnt(0)" ::: "memory");
    float rli[16];
#pragma unroll
    for (int r = 0; r < 16; ++r) rli[r] = __builtin_amdgcn_rcpf(wsf[32 + crow(r, hi)]);
#pragma unroll
    for (int r = 0; r < 16; ++r) { const int orow = crow(r, hi);
#pragma unroll
        for (int d0 = 0; d0 < 2; ++d0) { const float v = o[d0][r] * rli[r]; stg[orow * 64 + d0 * 32 + r32] = (bf16_t)(cvtpk_s(v, v) & 0xffffu); } }
    asm volatile("s_waitcnt lgkmcnt(0)" ::: "memory");
#pragma unroll
    for (int i = 0; i < 4; ++i) { const int row = i * 8 + (lane >> 3), ch = lane & 7;
        const u32x4 v = *(const ALDS u32x4*)(stg + row * 64 + ch * 8);
        const size_t off = (grow + row) * 1024 + ycol + ch * 8;
        const u32x4 g = *(const u32x4*)(G + off); u32x4 y;
#pragma unroll
        for (int k = 0; k < 4; ++k) y[k] = cvtpk_s(bf_lo(v[k]) * bf_lo(g[k]), bf_hi(v[k]) * bf_hi(g[k]));
        *(u32x4*)(Y + off) = y; }
    asm volatile("s_waitcnt lgkmcnt(0)" ::: "memory");
}

struct AttnPtrs { const bf16_t *QN, *QPE, *KN, *KPE, *V, *QS, *KS, *VS, *G; bf16_t* Y; const int* pos; const float *sinks, *relb, *COS, *SIN; };
constexpr int A_KV = 0;
constexpr int A_MLA_SLOT = 20480, A_MLA_V = 12288;
constexpr int A_SWA_V = 32768;
constexpr int A_WSF = 65536;
constexpr int A_OST = A_WSF + 8 * 256;
constexpr int A_KPOS = A_OST + 8 * 4096;
constexpr int A_TAB = A_KPOS + 1024;
constexpr int A_END = A_TAB + 4 * 132 * 4;

__device__ __forceinline__ void mla_unit(int b, int h, int qb, const AttnPtrs& P, ALDS char* shm) {
    const int tid = threadIdx.x, lane = tid & 63, r32 = lane & 31, hi = lane >> 5; const int wid = __builtin_amdgcn_readfirstlane(tid >> 6);
    const size_t rowbase = (size_t)b * SEQ; const int q0 = qb * 256, NT = (q0 + 256) / 64;
    const size_t qrow = rowbase + q0 + wid * 32 + r32;
    bf16x8 qr[6];
#pragma unroll
    for (int d0 = 0; d0 < 4; ++d0) qr[d0] = *(const bf16x8*)(P.QN + qrow * 512 + h * 64 + d0 * 16 + hi * 8);
#pragma unroll
    for (int d0 = 0; d0 < 2; ++d0) {
        const u32x4 w = *(const u32x4*)(P.QPE + qrow * 256 + h * 32 + d0 * 16 + hi * 8);
        const f32x4 c = *(const f32x4*)(P.COS + qrow * 16 + 4 * (2 * d0 + hi)), s = *(const f32x4*)(P.SIN + qrow * 16 + 4 * (2 * d0 + hi));
        const f32x4 x1 = {bf_lo(w[0]), bf_hi(w[0]), bf_lo(w[1]), bf_hi(w[1])}, x2 = {bf_lo(w[2]), bf_hi(w[2]), bf_lo(w[3]), bf_hi(w[3])};
        const f32x4 o1 = x1 * c - x2 * s, o2 = x2 * c + x1 * s;
        const u32x4 r = {cvtpk_s(o1[0], o1[1]), cvtpk_s(o1[2], o1[3]), cvtpk_s(o2[0], o2[1]), cvtpk_s(o2[2], o2[3])};
        qr[4 + d0] = __builtin_bit_cast(bf16x8, r); }
    const bf16_t* ksrc = P.KN + (rowbase + lane) * 512 + h * 64 + wid * 8;
    const bf16_t* kpsrc = P.KPE + (rowbase + lane) * 32 + (wid & 3) * 8;
    const bf16_t* vsrc = P.V + (rowbase + 16 * (wid & 3) + (lane >> 2)) * 512 + h * 64 + (wid >> 2) * 32 + (lane & 3) * 8;
    const int kdst = wid * 1024 + lane * 16, kpdst = (8 + (wid & 3)) * 1024 + lane * 16, vdst = A_MLA_V + wid * 1024 + lane * 16;
    ALDS float* wsf = (ALDS float*)(shm + A_WSF) + wid * 64;
    ALDS bf16_t* stg = (ALDS bf16_t*)(shm + A_OST) + wid * 2048;
    const int vb0 = (int)(unsigned)(uintptr_t)(shm + A_KV + A_MLA_V) + ((lane >> 4) & 1) * 32 + (lane & 3) * 8 + (4 * hi + ((lane & 15) >> 2)) * 64;
    float m = -1e30f, l = 0.f; f32x16 o[2]; o[0] = f32x16{}; o[1] = f32x16{};
    const int qrel = wid * 32 + r32;
    u32x4 kreg, kpreg = {0, 0, 0, 0}, vreg;
    kreg = *(const u32x4*)(ksrc); if (wid < 4) kpreg = *(const u32x4*)(kpsrc); vreg = *(const u32x4*)(vsrc);
    *(ALDS u32x4*)(shm + A_KV + kdst) = kreg; if (wid < 4) *(ALDS u32x4*)(shm + A_KV + kpdst) = kpreg; *(ALDS u32x4*)(shm + A_KV + vdst) = vreg;
    __syncthreads();
    for (int t = 0; t < NT; ++t) {
        const int boff = A_KV + (t & 1) * A_MLA_SLOT, noff = A_KV + ((t + 1) & 1) * A_MLA_SLOT;
        if (t + 1 < NT) { kreg = *(const u32x4*)(ksrc + (size_t)(t + 1) * 64 * 512); if (wid < 4) kpreg = *(const u32x4*)(kpsrc + (size_t)(t + 1) * 64 * 32); vreg = *(const u32x4*)(vsrc + (size_t)(t + 1) * 64 * 512); }
        f32x16 p0, p1;
        qkt<6>(p0, p1, shm + boff, qr, r32, hi);
        const int jb = t - (NT - 4);
        if (jb >= 0) { const int kb = 64 * jb + 4 * hi;
#pragma unroll
            for (int r = 0; r < 16; ++r) { const int kv = kb + (r & 3) + 8 * (r >> 2); if (kv > qrel) p0[r] = -INFINITY; if (kv + 32 > qrel) p1[r] = -INFINITY; } }
        softmax_pv(p0, p1, m, l, o, wsf, vb0 + (t & 1) * A_MLA_SLOT, r32, hi);
        if (t + 1 < NT) { *(ALDS u32x4*)(shm + noff + kdst) = kreg; if (wid < 4) *(ALDS u32x4*)(shm + noff + kpdst) = kpreg; *(ALDS u32x4*)(shm + noff + vdst) = vreg; }
        __syncthreads();
    }
    attn_epilogue(o, l, wsf, stg, P.G, P.Y, rowbase + q0 + wid * 32, h * 64, lane, r32, hi);
}

__device__ __forceinline__ int t5_bucket(int n) {
    if (n < 16) return n;
    const int large = 16 + (int)(__logf((float)n * (1.0f / 16.0f)) / 2.0794415416798357f * 16.0f);
    return large < 31 ? large : 31;
}
__device__ __forceinline__ void swa_unit(int b, int kvh, int blk, const AttnPtrs& P, ALDS char* shm) {
    const int tid = threadIdx.x, lane = tid & 63, r32 = lane & 31, hi = lane >> 5; const int wid = __builtin_amdgcn_readfirstlane(tid >> 6);
    const size_t rowbase = (size_t)b * SEQ; const int kb0 = blk * 128 - 128;
    ALDS int* kposL = (ALDS int*)(shm + A_KPOS); ALDS float* tab = (ALDS float*)(shm + A_TAB);
    const int t_first = (blk == 0) ? 2 : 0;
    for (int tt = t_first; tt < 4; ++tt) {
        const size_t krow = rowbase + kb0 + tt * 64;
        const u32x4 kreg = *(const u32x4*)(P.KS + (krow + lane) * 128 + kvh * 64 + wid * 8);
        const u32x4 vreg = *(const u32x4*)(P.VS + (krow + 16 * (wid & 3) + (lane >> 2)) * 128 + kvh * 64 + (wid >> 2) * 32 + (lane & 3) * 8);
        *(ALDS u32x4*)(shm + A_KV + tt * 8192 + wid * 1024 + lane * 16) = kreg;
        *(ALDS u32x4*)(shm + A_SWA_V + tt * 8192 + wid * 1024 + lane * 16) = vreg;
    }
    if (tid < 256) kposL[tid] = (kb0 + tid >= 0) ? P.pos[rowbase + kb0 + tid] : 0;
    for (int i = tid; i < 4 * 129; i += 512) { const int g = i / 129, n = i - g * 129; tab[g * 132 + n] = P.relb[t5_bucket(n) * 8 + kvh * 4 + g] * LOG2E; }
    __syncthreads();
    ALDS float* wsf = (ALDS float*)(shm + A_WSF) + wid * 64;
    ALDS bf16_t* stg = (ALDS bf16_t*)(shm + A_OST) + wid * 2048;
    const int g = wid & 3, hq = kvh * 4 + g;
    const int vb0 = (int)(unsigned)(uintptr_t)(shm + A_SWA_V) + ((lane >> 4) & 1) * 32 + (lane & 3) * 8 + (4 * hi + ((lane & 15) >> 2)) * 64;
    const float sink2 = P.sinks[hq] * LOG2E;
    for (int jj = 0; jj < 2; ++jj) {
        const int j = (wid >> 2) * 2 + jj;
        const size_t qrow = rowbase + blk * 128 + j * 32 + r32;
        bf16x8 qr[4];
#pragma unroll
        for (int d0 = 0; d0 < 4; ++d0) qr[d0] = *(const bf16x8*)(P.QS + qrow * 512 + hq * 64 + d0 * 16 + hi * 8);
        const int qpos = P.pos[qrow], qband = 128 + j * 32 + r32;
        float m = sink2, l = (hi == 0) ? 1.0f : 0.0f; f32x16 o[2]; o[0] = f32x16{}; o[1] = f32x16{};
        const int tlo = (wid >> 2);
        for (int tt = tlo; tt < tlo + 3; ++tt) {
            if (tt < t_first) continue;
            f32x16 p0, p1;
            qkt<4>(p0, p1, shm + A_KV + tt * 8192, qr, r32, hi);
#pragma unroll
            for (int r = 0; r < 16; ++r) {
#pragma unroll
                for (int hf = 0; hf < 2; ++hf) {
                    const int kk = tt * 64 + crow(r, hi) + 32 * hf, delta = qband - kk;
                    int n = qpos - kposL[kk]; n = n < 0 ? 0 : (n > 128 ? 128 : n);
                    const float bias = tab[g * 132 + n];
                    const float s = (hf ? p1[r] : p0[r]) + bias;
                    const float v = (delta >= 0 && delta < 128) ? s : -INFINITY;
                    if (hf) p1[r] = v; else p0[r] = v; } }
            softmax_pv(p0, p1, m, l, o, wsf, vb0 + tt * 8192, r32, hi);
        }
        attn_epilogue(o, l, wsf, stg, P.G, P.Y, rowbase + blk * 128 + j * 32, 512 + hq * 64, lane, r32, hi);
    }
    __syncthreads();
}
}
#define GAS __attribute__((address_space(1)))
#define LAS __attribute__((address_space(3)))
typedef unsigned short bf16;
typedef unsigned v4u __attribute__((ext_vector_type(4)));
typedef float f32x4 __attribute__((ext_vector_type(4)));
typedef short bf16x8 __attribute__((ext_vector_type(8)));
typedef GAS unsigned gu32;
typedef GAS unsigned long long gu64;
#define RLX_AGENT __ATOMIC_RELAXED, __HIP_MEMORY_SCOPE_AGENT
#define LDS_WAIT() asm volatile("s_waitcnt lgkmcnt(0)" ::: "memory")
#define VM_WAIT() asm volatile("s_waitcnt vmcnt(0)" ::: "memory")
__device__ __forceinline__ unsigned long long rt() { return __builtin_amdgcn_s_memrealtime(); }
__device__ __forceinline__ unsigned f2bf(float f) { unsigned u = __builtin_bit_cast(unsigned, f); return (u + 0x7fffu + ((u >> 16) & 1u)) >> 16; }
__device__ __forceinline__ unsigned pk2(float lo, float hi) { return f2bf(lo) | (f2bf(hi) << 16); }

#define XB_TMO      128
#define XB_XCNT(j)  (256  + 64 * (j))
#define XB_XSUB(j)  (1280 + 64 * (j))
#define XB_XGEN(j)  (2304 + 64 * (j))
#define XB_TOP      3328
#define XB_TOPGEN   3392
#define XCD_BAR_WORDS 3456
#define XB_SPIN_CAP (1u << 18)

__device__ __forceinline__ unsigned xb_ld(unsigned* p)              { return __hip_atomic_load(p, __ATOMIC_RELAXED, __HIP_MEMORY_SCOPE_AGENT); }
__device__ __forceinline__ unsigned xb_add(unsigned* p, unsigned v) { return __hip_atomic_fetch_add(p, v, __ATOMIC_RELAXED, __HIP_MEMORY_SCOPE_AGENT); }
__device__ __forceinline__ unsigned xb_xcc_id() { return (unsigned)__builtin_amdgcn_s_getreg((3 << 11) | 20) & 0xFu; }
#define XB_SPIN(cond, bar) do { unsigned _sp = 0; while (cond) { __builtin_amdgcn_s_sleep(1); \
    if ((++_sp & 255u) == 0u) { if (xb_ld(&(bar)[XB_TMO])) break; if (_sp > XB_SPIN_CAP) { atomicAdd(&(bar)[XB_TMO], 1u); break; } } } } while (0)

struct XcdBarrier {
    unsigned* bar; unsigned x;
    volatile LAS unsigned* st;
};

__device__ __forceinline__ XcdBarrier xcd_barrier_post(unsigned* bar, volatile LAS unsigned* st) {
    XcdBarrier b; b.bar = bar; b.x = xb_xcc_id(); b.st = st;
    if (threadIdx.x == 0) (void)xb_add(&bar[XB_XCNT(b.x)], 1u);
    return b;
}
__device__ __forceinline__ void xcd_barrier_complete(unsigned* bar, unsigned x, unsigned& nloc, unsigned& nx) {
    const unsigned G = gridDim.x * gridDim.y * gridDim.z;
    unsigned sum, cnt, mine, sp = 0u;
    for (;;) {
        sum = 0u; cnt = 0u; mine = 0u;
#pragma unroll
        for (unsigned j = 0; j < 16; ++j) { const unsigned c = xb_ld(&bar[XB_XCNT(j)]); sum += c; cnt += (c > 0u) ? 1u : 0u; mine = (j == x) ? c : mine; }
        if (sum == G) break;
        __builtin_amdgcn_s_sleep(1);
        if ((++sp & 255u) == 0u) { if (xb_ld(&bar[XB_TMO])) break; if (sp > XB_SPIN_CAP) { atomicAdd(&bar[XB_TMO], 1u); break; } }
    }
    nloc = mine > 0u ? mine : 1u; nx = cnt > 0u ? cnt : 1u;
}

__device__ __forceinline__ void xcd_barrier(const XcdBarrier& b) {
    asm volatile("s_waitcnt vmcnt(0)" ::: "memory");
    __syncthreads();
    if (threadIdx.x == 0) {
        unsigned* bar = b.bar;
        __builtin_amdgcn_s_waitcnt(0);
        unsigned nloc = b.st[0], nx = b.st[1];
        if (nloc == 0u) { xcd_barrier_complete(bar, b.x, nloc, nx); b.st[0] = nloc; b.st[1] = nx; }
        const unsigned old = xb_add(&bar[XB_XSUB(b.x)], 1u);
        const unsigned gen = old / nloc;
        if (old + 1u == (gen + 1u) * nloc) {
            __builtin_amdgcn_fence(__ATOMIC_RELEASE, "agent");
            asm volatile("s_waitcnt vmcnt(0)" ::: "memory");
            const unsigned og = xb_add(&bar[XB_TOP], 1u);
            const unsigned tg = og / nx;
            if (og + 1u == (tg + 1u) * nx) xb_add(&bar[XB_TOPGEN], 1u);
            else XB_SPIN(xb_ld(&bar[XB_TOPGEN]) == tg, bar);
            __builtin_amdgcn_fence(__ATOMIC_ACQUIRE, "agent");
            xb_add(&bar[XB_XGEN(b.x)], 1u);
            asm volatile("s_waitcnt vmcnt(0)" ::: "memory");
        } else {
            XB_SPIN(xb_ld(&bar[XB_XGEN(b.x)]) == gen, bar);
            __builtin_amdgcn_fence(__ATOMIC_ACQUIRE, "agent");
            asm volatile("s_waitcnt vmcnt(0)" ::: "memory");
        }
    }
    __syncthreads();
}
constexpr int NWAVES = 8;
#ifndef MK_N_LAUNCHES
#define MK_N_LAUNCHES 1
#endif
constexpr int N_LAUNCHES = MK_N_LAUNCHES;
constexpr int PER_PHASE = 6;
constexpr int BATCH = 4, T = 8192, D = 1024, M = BATCH * T;
constexpr int IN_W = 2208, NP1 = 2304;
constexpr float EPS = 1e-6f;
constexpr float C2_MLA = 0.14724444602590306f;
constexpr float C2_SWA = 0.18033688011112042f;

constexpr size_t MiB = 1u << 20;
constexpr size_t WS_CTL = 0, CTL_ZERO_BYTES = 1 * MiB;
constexpr size_t WS_WQ = 1 * MiB, WS_WKV = 1 * MiB + 512 * 1024, WS_WIN = 2 * MiB, WS_WOUT = 7 * MiB;
constexpr size_t WS_COS = 9 * MiB, WS_SIN = 11 * MiB, WS_PQ = 13 * MiB, WS_PKV = 13 * MiB + 512 * 1024;
constexpr size_t WS_QL = 16 * MiB, WS_KVL = 32 * MiB, WS_KS = 40 * MiB, WS_VS = 48 * MiB, WS_KPE = 56 * MiB;
constexpr size_t WS_QS = 64 * MiB, WS_G = 96 * MiB, WS_XN = 160 * MiB;
constexpr size_t WS_QN = 224 * MiB, WS_QPE = 256 * MiB, WS_KN = 272 * MiB, WS_V = 304 * MiB, WS_Y = 336 * MiB, WS_END = 400 * MiB;
constexpr int CW_TMO = 0, CW_CODE = 1, CW_BAR = 4096;

constexpr int RING_OFF = 0, RING_BYTES = 131072;
constexpr int LDSCTL_OFF = RING_BYTES, MISC_OFF = LDSCTL_OFF + 320;
constexpr int LDS_BYTES = 147456;
static_assert(att::A_END <= RING_BYTES, "attention scratch inside the ring region");

__device__ __forceinline__ float wave_sum(float v) {
#pragma unroll
    for (int o = 1; o < 64; o <<= 1) v += __shfl_xor(v, o);
    return v;
}
__device__ __forceinline__ void p0_transpose_item(const float* W, int N, int k0, int n0, const float* gain, bf16* WT, int K, int drow0, bool perm, LAS float* scr, int lane) {
#pragma unroll 8
    for (int i = 0; i < 32; ++i) { const int kk = 2 * i + (lane >> 5); const float g = gain ? gain[k0 + kk] : 1.0f; scr[kk * 33 + (lane & 31)] = W[(size_t)(k0 + kk) * N + n0 + (lane & 31)] * g; }
    LDS_WAIT(); asm volatile("" ::: "memory");
    const int c = lane & 7;
#pragma unroll
    for (int j = 0; j < 4; ++j) { const int n = (lane >> 3) + 8 * j; const LAS float* s = scr + (8 * c) * 33 + n;
        v4u o; o.x = pk2(s[0 * 33], s[1 * 33]); o.y = pk2(s[2 * 33], s[3 * 33]); o.z = pk2(s[4 * 33], s[5 * 33]); o.w = pk2(s[6 * 33], s[7 * 33]);
        const int dn = perm ? (8 * ((n & 15) >> 2) + 4 * (n >> 4) + (n & 3)) : n;
        *(GAS v4u*)(WT + (size_t)(drow0 + dn) * K + k0 + 8 * c) = o; }
    LDS_WAIT(); asm volatile("" ::: "memory");
}
__device__ __forceinline__ int win_dest_row(int n0) {
    if (n0 < 384) return n0;
    if (n0 < 416) return 640;
    if (n0 < 928) return 768 + (n0 - 416);
    if (n0 < 1056) return 384 + (n0 - 928);
    if (n0 < 1184) return 512 + (n0 - 1056);
    return 1280 + (n0 - 1184);
}
__constant__ float ROPE_INV[16] = {1.0f, 0.5623413251903491f, 0.31622776601683794f, 0.1778279410038923f, 0.1f, 0.05623413251903491f, 0.03162277660168379f, 0.01778279410038923f,
    0.01f, 0.005623413251903491f, 0.0031622776601683794f, 0.0017782794100389228f, 0.001f, 0.0005623413251903491f, 0.00031622776601683794f, 0.00017782794100389227f};

struct Args { const float* in[12]; const int* pos; float* out; unsigned char* ws; int ph_lo, ph_hi, li, pad; };

__global__ void __launch_bounds__(NWAVES * 64, 2) fwd_kernel(Args args) {
    extern __shared__ __attribute__((aligned(16))) unsigned char lds[];
    LAS unsigned char* L = (LAS unsigned char*)lds;
    volatile LAS unsigned* MISC = (volatile LAS unsigned*)(L + MISC_OFF);
    const int tid = threadIdx.x, lane = tid & 63, wave = __builtin_amdgcn_readfirstlane(tid >> 6);
    const int G = gridDim.x, bx = blockIdx.x, vcu = (G % 8 == 0) ? (bx % 8) * (G / 8) + bx / 8 : bx;
    unsigned char* ws = args.ws;
    gu32* ctl = (gu32*)(ws + WS_CTL);
    const float* x = args.in[0];
    bf16* Wq_t = (bf16*)(ws + WS_WQ); bf16* Wkv_t = (bf16*)(ws + WS_WKV); bf16* Win_t = (bf16*)(ws + WS_WIN); bf16* Wout_t = (bf16*)(ws + WS_WOUT);
    float* COS = (float*)(ws + WS_COS); float* SIN = (float*)(ws + WS_SIN); float* PQ = (float*)(ws + WS_PQ); float* PKV = (float*)(ws + WS_PKV);
    bf16 *QL = (bf16*)(ws + WS_QL), *KVL = (bf16*)(ws + WS_KVL), *KS = (bf16*)(ws + WS_KS), *VS = (bf16*)(ws + WS_VS), *KPE = (bf16*)(ws + WS_KPE);
    bf16 *QS = (bf16*)(ws + WS_QS), *GT = (bf16*)(ws + WS_G), *XN = (bf16*)(ws + WS_XN);
    bf16 *QN = (bf16*)(ws + WS_QN), *QPE = (bf16*)(ws + WS_QPE), *KN = (bf16*)(ws + WS_KN), *VV = (bf16*)(ws + WS_V), *Y = (bf16*)(ws + WS_Y);

    for (int u = tid; u < (LDS_BYTES - LDSCTL_OFF) / 4; u += NWAVES * 64) ((LAS unsigned*)(L + LDSCTL_OFF))[u] = 0u;
    __syncthreads();
    XcdBarrier bar; bar.bar = (unsigned*)(ctl + CW_BAR); bar.x = 0; bar.st = nullptr;
    if (N_LAUNCHES != PER_PHASE) bar = xcd_barrier_post((unsigned*)(ctl + CW_BAR), MISC + 8);
#define GRID_BAR(seam) do { if (N_LAUNCHES == PER_PHASE) { if (tid == 0) __hip_atomic_store(ctl + CW_TMO, 0xBADBA0u | (unsigned)(seam), RLX_AGENT); } else { xcd_barrier(bar); } } while (0)
    const int lo = args.ph_lo, hi = args.ph_hi;
#ifndef PH_MASK
#define PH_MASK 63
#endif
#define IN(k) (((PH_MASK >> (k)) & 1) && lo <= (k) && (k) < hi)
#define BOTH(k) (IN(k) && IN((k) + 1))

    if (IN(0)) {
        LAS float* scr = (LAS float*)(L + RING_OFF + wave * 16384);
        const int gw = vcu * NWAVES + wave, NGW = G * NWAVES;
        constexpr int I_IN = 16 * 69, I_Q = 4 * 24, I_KV = 2 * 32, I_OUT = 16 * 32, NITEMS = I_IN + I_Q + I_KV + I_OUT;
        for (int it = gw; it < NITEMS; it += NGW) {
            int r = it;
            if (r < I_IN) { const int kb = r / 69, cb = r % 69, n0 = 32 * cb; p0_transpose_item(args.in[3], IN_W, 64 * kb, n0, args.in[2], Win_t, 1024, win_dest_row(n0), cb == 12, scr, lane); continue; } r -= I_IN;
            if (r < I_Q) { const int kb = r / 24, cb = r % 24, h = cb / 3, part = cb % 3; p0_transpose_item(args.in[5], 768, 64 * kb, 32 * cb, args.in[4], Wq_t, 256, part < 2 ? h * 64 + part * 32 : 512 + h * 32, part == 2, scr, lane); continue; } r -= I_Q;
            if (r < I_KV) { const int kb = r / 32, cb = r % 32, h = cb / 4, part = cb % 4; p0_transpose_item(args.in[7], 1024, 64 * kb, 32 * cb, args.in[6], Wkv_t, 128, part < 2 ? h * 64 + part * 32 : 512 + h * 64 + (part - 2) * 32, false, scr, lane); continue; } r -= I_KV;
            { const int kb = r / 32, cb = r % 32; p0_transpose_item(args.in[10], 1024, 64 * kb, 32 * cb, nullptr, Wout_t, 1024, 32 * cb, false, scr, lane); }
        }
        { const int gt = vcu * (NWAVES * 64) + tid, NGT = G * NWAVES * 64; for (int i = gt; i < 96 * 1024 / 8; i += NGT) ((GAS v4u*)(Win_t + 672 * 1024))[i] = (v4u){0u, 0u, 0u, 0u};
          for (int e = gt; e < M * 16; e += NGT) { const int m = e >> 4, i = e & 15; const float a = (float)args.pos[m] * ROPE_INV[i];
              const double rev = (double)a * 0.15915494309189535; const float fr = (float)(rev - __builtin_rint(rev));
              COS[e] = __builtin_amdgcn_cosf(fr); SIN[e] = __builtin_amdgcn_sinf(fr); } }
        for (int m = gw; m < M; m += NGW) {
            const GAS f32x4* xr = (const GAS f32x4*)(x + (size_t)m * D) + lane; f32x4 v[4]; float s = 0.f;
#pragma unroll
            for (int j = 0; j < 4; ++j) { v[j] = xr[64 * j]; s += (v[j].x * v[j].x + v[j].y * v[j].y) + (v[j].z * v[j].z + v[j].w * v[j].w); }
            const float rstd = 1.0f / sqrtf(wave_sum(s) * (1.0f / D) + EPS);
            GAS unsigned long long* o8 = (GAS unsigned long long*)(XN + (size_t)m * D) + lane;
#pragma unroll
            for (int j = 0; j < 4; ++j) o8[64 * j] = (unsigned long long)pk2(v[j].x * rstd, v[j].y * rstd) | ((unsigned long long)pk2(v[j].z * rstd, v[j].w * rstd) << 32);
        }
        if (BOTH(0)) GRID_BAR(0);
    }
    if (IN(1)) {
        pg8::Gemm g{XN, Win_t, M, NP1, D}; pg8::StaticOrder S; S.init(M, NP1, G, bx);
        pg8::EpiProj E{QL, KVL, KS, VS, KPE, QS, GT, PQ, PKV, COS, SIN, C2_SWA};
        pg8::gemm_phase<pg8::EpiProj, pg8::StaticOrder, PG8_ALIGN, PG8_SP2>(L + RING_OFF, g, S, E);
        if (BOTH(1)) GRID_BAR(1);
    }
    if (IN(2)) {
#pragma clang loop unroll(disable)
        for (int gi = 0; gi < 2; ++gi) {
            const pg8::Gemm g = (gi == 0) ? pg8::Gemm{QL, Wq_t, M, 768, 256} : pg8::Gemm{KVL, Wkv_t, M, 1024, 128};
            const pg8::EpiRS E = (gi == 0) ? pg8::EpiRS{QN, QPE, 256, PQ, 1.0f / 256.0f, C2_MLA, EPS} : pg8::EpiRS{KN, VV, 512, PKV, 1.0f / 128.0f, 1.0f, EPS};
            pg8::StaticOrder S; S.init(M, g.N, G, bx);
            pg8::gemm_phase<pg8::EpiRS, pg8::StaticOrder, PG8_ALIGN, PG8_SP2>(L + RING_OFF, g, S, E);
        }
        if (BOTH(2)) GRID_BAR(2);
    }
    if (IN(3)) {
        att::AttnPtrs P{QN, QPE, KN, KPE, VV, QS, KS, VS, GT, Y, args.pos, args.in[8], args.in[9], COS, SIN};
        ALDS char* shm = (ALDS char*)(L + RING_OFF);
        if (G == 256) {
            const int bh = vcu >> 3, s = vcu & 7;
            for (int i = 0; i < 4; ++i) { const int qb = (i == 0) ? s : (i == 1) ? 15 - s : (i == 2) ? 16 + s : 31 - s; att::mla_unit(bh >> 3, bh & 7, qb, P, shm); }
        } else {
            for (int u = bx; u < 1024; u += G) att::mla_unit(u >> 8, (u >> 5) & 7, u & 31, P, shm);
        }
        for (int u = bx; u < 512; u += G) att::swa_unit(u >> 7, (u >> 6) & 1, u & 63, P, shm);
        if (BOTH(3)) GRID_BAR(3);
    }
    if (IN(4)) {
        pg8::Gemm g{Y, Wout_t, M, D, D}; pg8::StaticOrder S; S.init(M, D, G, bx);
        pg8::EpiOut E{x, args.out};
        pg8::gemm_phase<pg8::EpiOut, pg8::StaticOrder, PG8_ALIGN, PG8_SP2>(L + RING_OFF, g, S, E);
        if (BOTH(4)) GRID_BAR(4);
    }
    if (IN(5)) {
        const int gw = vcu * NWAVES + wave, NGW = G * NWAVES; const float* fn = args.in[11];
        f32x4 gv[4];
#pragma unroll
        for (int j = 0; j < 4; ++j) gv[j] = ((const GAS f32x4*)fn)[lane + 64 * j];
        for (int m = gw; m < M; m += NGW) {
            GAS f32x4* xr = (GAS f32x4*)(args.out + (size_t)m * D) + lane; f32x4 v[4]; float s = 0.f;
#pragma unroll
            for (int j = 0; j < 4; ++j) { v[j] = xr[64 * j]; s += (v[j].x * v[j].x + v[j].y * v[j].y) + (v[j].z * v[j].z + v[j].w * v[j].w); }
            const float rstd = 1.0f / sqrtf(wave_sum(s) * (1.0f / D) + EPS);
#pragma unroll
            for (int j = 0; j < 4; ++j) xr[64 * j] = v[j] * rstd * gv[j];
        }
    }
#undef IN
#undef BOTH
}

extern "C" void kernel_launch(void* const* d_in, const int* in_sizes, int n_in, void* d_out, int out_size, void* d_ws, size_t ws_size, hipStream_t stream) {
    static int grid = 0;
    if (grid == 0) {
        if (n_in != 12 || in_sizes[0] != M * D || out_size != M * D || ws_size < WS_END) { fprintf(stderr, "kernel_launch: unexpected shapes (n_in %d, in0 %d, out %d, ws %zu)\n", n_in, n_in > 0 ? in_sizes[0] : -1, out_size, ws_size); grid = -1; return; }
        int dev = 0, cus = 0;
        if (hipGetDevice(&dev) != hipSuccess || hipDeviceGetAttribute(&cus, hipDeviceAttributeMultiprocessorCount, dev) != hipSuccess) { grid = -1; return; }
        if (hipFuncSetAttribute((const void*)fwd_kernel, hipFuncAttributeMaxDynamicSharedMemorySize, LDS_BYTES) != hipSuccess) { fprintf(stderr, "kernel_launch: hipFuncSetAttribute failed\n"); grid = -1; return; }
        int per_cu = 0;
        if (hipOccupancyMaxActiveBlocksPerMultiprocessor(&per_cu, (const void*)fwd_kernel, NWAVES * 64, LDS_BYTES) != hipSuccess || per_cu < 1) fprintf(stderr, "kernel_launch: occupancy query says %d\n", per_cu);
        (void)hipGetLastError();
        grid = cus;
    }
    if (grid < 0) return;
    (void)hipMemsetAsync((char*)d_ws + WS_CTL, 0, CTL_ZERO_BYTES, stream);
    Args a{};
    for (int i = 0; i < 12; ++i) a.in[i] = (const float*)d_in[i];
    a.pos = (const int*)d_in[1]; a.out = (float*)d_out; a.ws = (unsigned char*)d_ws;
    if (N_LAUNCHES == 1) { a.ph_lo = 0; a.ph_hi = PER_PHASE; a.li = 0; hipLaunchKernelGGL(fwd_kernel, dim3(grid), dim3(NWAVES * 64), LDS_BYTES, stream, a); }
    else for (int li = 0; li < PER_PHASE; ++li) { a.ph_lo = li; a.ph_hi = li + 1; a.li = li; hipLaunchKernelGGL(fwd_kernel, dim3(grid), dim3(NWAVES * 64), LDS_BYTES, stream, a); }
}
```

```cpp
#include <hip/hip_runtime.h>
#include <hip/hip_bf16.h>
#include <cstdio>
#include <cstdint>
#include <cmath>
namespace pg8 {
#define PG8_LAS __attribute__((address_space(3)))
typedef unsigned short bf16_t;
typedef short bf16x8 __attribute__((ext_vector_type(8)));
typedef float f32x4 __attribute__((ext_vector_type(4)));
typedef unsigned u32x4 __attribute__((ext_vector_type(4)));
constexpr int BM = 256, BK = 64, HALF = 128, HTB = HALF * BK * 2  , STAGE_BYTES = 8 * HTB, NXCD = 8, WGM = 8;

__host__ __device__ __forceinline__ int lds_byte(int r, int c) { const int st = (r >> 4) * 2 + (c >> 5), rr = r & 15, cc = c & 31, ob = rr * 64 + cc * 2; return st * 1024 + (ob ^ (((ob >> 9) & 1) << 5)); }
__host__ __device__ __forceinline__ void stage_rc(int b, int& R, int& C) { const int st = b / 1024, sb = b % 1024, swz = sb ^ (((sb >> 9) & 1) << 5); R = (st >> 1) * 16 + swz / 64; C = (st & 1) * 32 + (swz % 64) / 2; }
__host__ __device__ __forceinline__ int perm32(int rho) { const int n = rho >> 4, i = rho & 15; return 8 * (i >> 2) + 4 * n + (i & 3); }

struct Unit { int pm, pn; };
struct Gemm { const bf16_t* A; const bf16_t* Bt; int M, N, K; };

struct StaticOrder {
    int nM, nN, nwg, G, c;
    __host__ __device__ void init(int M, int N, int G_, int c_) { nM = M / BM; nN = N / BM; nwg = nM * nN; G = G_; c = c_; }
    __host__ __device__ bool next(int i, Unit& u) const {
        const long L = (long)i * G + c; if (L >= nwg) return false;
        int wgid = (int)L; { const int q = nwg / NXCD, r = nwg % NXCD, xcd = wgid % NXCD, off = wgid / NXCD; wgid = (xcd < r ? xcd * (q + 1) : r * (q + 1) + (xcd - r) * q) + off; }
        const int nig = WGM * nN, gid = wgid / nig, fm = gid * WGM, gsz = (nM - fm) < WGM ? (nM - fm) : WGM;
        u.pm = fm + ((wgid % nig) % gsz); u.pn = (wgid % nig) / gsz; return true;
    }
    __device__ __forceinline__ void a_ready(const Unit&) const {}
    __device__ __forceinline__ void done(const Unit&) const {}
};

__device__ __forceinline__ unsigned cvt_pk_bf16(float lo, float hi) { unsigned r; asm volatile("v_cvt_pk_bf16_f32 %0, %1, %2" : "=v"(r) : "v"(lo), "v"(hi)); return r; }
typedef float f32x2 __attribute__((ext_vector_type(2)));
typedef float f32x2 __attribute__((ext_vector_type(2)));
typedef unsigned u32x2 __attribute__((ext_vector_type(2)));
__device__ __forceinline__ u32x4 pack8(f32x4 v0, f32x4 v1) { u32x4 w; w.x = cvt_pk_bf16(v0[0], v0[1]); w.y = cvt_pk_bf16(v0[2], v0[3]); w.z = cvt_pk_bf16(v1[0], v1[1]); w.w = cvt_pk_bf16(v1[2], v1[3]); return w; }
__device__ __forceinline__ float silu_f(float v) { return v * __builtin_amdgcn_rcpf(1.0f + __builtin_amdgcn_exp2f(-1.4426950408889634f * v)); }
__device__ __forceinline__ float sq4(f32x4 v) { return (v[0] * v[0] + v[1] * v[1]) + (v[2] * v[2] + v[3] * v[3]); }

struct EpiProj {
    static constexpr bool PERM = true, AFTER_DRAIN = false;
    bf16_t *QL, *KVL, *KS, *VS, *KPE, *QS, *G; float *PQ, *PKV; const float *COS, *SIN; float qs_scale;
    __device__ __forceinline__ void operator()(const f32x4 (&acc)[2][2][4][2], const Unit& u, int wr, int wc, int fr, int fq) const {
        const int row0 = u.pm * BM + wr * 64 + fr, pn = u.pn, cw = wc * 32 + 8 * fq;
        if (pn == 0) {
#pragma unroll
            for (int ai = 0; ai < 2; ++ai)
#pragma unroll
                for (int m = 0; m < 4; ++m) { const size_t row = (size_t)(row0 + ai * HALF + m * 16); float s = 0.f;
#pragma unroll
                    for (int bj = 0; bj < 2; ++bj) { s += sq4(acc[ai][bj][m][0]) + sq4(acc[ai][bj][m][1]); *(u32x4*)(QL + row * 256 + bj * HALF + cw) = pack8(acc[ai][bj][m][0], acc[ai][bj][m][1]); }
                    s += __shfl_xor(s, 16); s += __shfl_xor(s, 32);
                    if (fq == 0) PQ[row * 4 + wc] = s; }
        } else if (pn == 1) {
#pragma unroll
            for (int ai = 0; ai < 2; ++ai)
#pragma unroll
                for (int m = 0; m < 4; ++m) { const size_t row = (size_t)(row0 + ai * HALF + m * 16);
                    float s = sq4(acc[ai][0][m][0]) + sq4(acc[ai][0][m][1]);
                    *(u32x4*)(KVL + row * 128 + cw) = pack8(acc[ai][0][m][0], acc[ai][0][m][1]);
                    *(u32x4*)(KS + row * 128 + cw) = pack8(acc[ai][1][m][0], acc[ai][1][m][1]);
                    s += __shfl_xor(s, 16); s += __shfl_xor(s, 32);
                    if (fq == 0) PKV[row * 4 + wc] = s; }
        } else if (pn == 2) {
#pragma unroll
            for (int ai = 0; ai < 2; ++ai)
#pragma unroll
                for (int m = 0; m < 4; ++m) { const size_t row = (size_t)(row0 + ai * HALF + m * 16);
                    *(u32x4*)(VS + row * 128 + cw) = pack8(acc[ai][0][m][0], acc[ai][0][m][1]);
                    if (wc == 0) { const f32x4 c = *(const f32x4*)(COS + row * 16 + 4 * fq), s = *(const f32x4*)(SIN + row * 16 + 4 * fq);
                        const f32x4 x1 = acc[ai][1][m][0], x2 = acc[ai][1][m][1];
                        *(u32x4*)(KPE + row * 32 + 8 * fq) = pack8(x1 * c - x2 * s, x2 * c + x1 * s); }
                    asm volatile("" ::: "memory"); }
        } else if (pn < 5) {
            const int c0 = (pn - 3) * 256 + cw;
#pragma unroll
            for (int ai = 0; ai < 2; ++ai)
#pragma unroll
                for (int m = 0; m < 4; ++m) { const size_t row = (size_t)(row0 + ai * HALF + m * 16);
#pragma unroll
                    for (int bj = 0; bj < 2; ++bj) *(u32x4*)(QS + row * 512 + c0 + bj * HALF) = pack8(acc[ai][bj][m][0] * qs_scale, acc[ai][bj][m][1] * qs_scale); }
        } else {
            const int c0 = (pn - 5) * 256 + cw;
#pragma unroll
            for (int ai = 0; ai < 2; ++ai)
#pragma unroll
                for (int m = 0; m < 4; ++m) { const size_t row = (size_t)(row0 + ai * HALF + m * 16);
#pragma unroll
                    for (int bj = 0; bj < 2; ++bj) { f32x4 a = acc[ai][bj][m][0], b = acc[ai][bj][m][1];
#pragma unroll
                        for (int j = 0; j < 4; ++j) { a[j] = silu_f(a[j]); b[j] = silu_f(b[j]); }
                        *(u32x4*)(G + row * 1024 + c0 + bj * HALF) = pack8(a, b); } }
        }
    }
};
struct EpiRS {
    static constexpr bool PERM = true, AFTER_DRAIN = false;
    bf16_t *D0, *D1; int p1; const float* PP; float inv_n, scale, eps;
    __device__ __forceinline__ void operator()(const f32x4 (&acc)[2][2][4][2], const Unit& u, int wr, int wc, int fr, int fq) const {
        const int row0 = u.pm * BM + wr * 64 + fr, pn = u.pn, cw = wc * 32 + 8 * fq;
        bf16_t* dst = (pn < 2) ? D0 : D1; const int pitch = (pn < 2) ? 512 : p1, c0 = (pn & 1) * 256 + cw;
#pragma unroll
        for (int ai = 0; ai < 2; ++ai)
#pragma unroll
            for (int m = 0; m < 4; ++m) { const size_t row = (size_t)(row0 + ai * HALF + m * 16);
                const f32x4 pq = *(const f32x4*)(PP + row * 4);
                const float rs = __builtin_amdgcn_rsqf(((pq[0] + pq[1]) + (pq[2] + pq[3])) * inv_n + eps) * scale;
#pragma unroll
                for (int bj = 0; bj < 2; ++bj) *(u32x4*)(dst + row * pitch + c0 + bj * HALF) = pack8(acc[ai][bj][m][0] * rs, acc[ai][bj][m][1] * rs);
                asm volatile("" ::: "memory"); }
    }
};
struct EpiOut {
    static constexpr bool PERM = false, AFTER_DRAIN = false;
    const float* X; float* O;
    __device__ __forceinline__ void operator()(const f32x4 (&acc)[2][2][4][2], const Unit& u, int wr, int wc, int fr, int fq) const {
        const int row0 = u.pm * BM + wr * 64 + fr, col0 = u.pn * BM + wc * 32 + 4 * fq;
#pragma unroll
        for (int ai = 0; ai < 2; ++ai)
#pragma unroll
            for (int m = 0; m < 4; ++m) { const size_t off = (size_t)(row0 + ai * HALF + m * 16) * 1024 + col0;
#pragma unroll
                for (int bj = 0; bj < 2; ++bj)
#pragma unroll
                    for (int n = 0; n < 2; ++n) { const f32x4 xv = *(const f32x4*)(X + off + bj * HALF + n * 16); *(f32x4*)(O + off + bj * HALF + n * 16) = xv + acc[ai][bj][m][n]; }
                if (m & 1) asm volatile("" ::: "memory"); }
    }
};
template <class Epi, class Sched, bool ALIGN_EPI = false, bool SP2 = false>
__device__ __forceinline__ void gemm_phase(PG8_LAS unsigned char* lds, const Gemm g, const Sched& S, const Epi& E) {
    const int tid = threadIdx.x, wid = __builtin_amdgcn_readfirstlane(tid >> 6), lane = tid & 63, wr = wid >> 2, wc = wid & 3, fr = lane & 15, fq = lane >> 4;
    const int K = g.K, nt = K / BK;
    unsigned voffA[2], voffB[2];
#pragma unroll
    for (int i = 0; i < 2; ++i) { int R, C; stage_rc(tid * 16 + i * 8192, R, C); const int Rb = Epi::PERM ? ((R & ~31) + perm32(R & 31)) : R;
        voffA[i] = (unsigned)(R * K + C) * 2u; voffB[i] = (unsigned)(Rb * K + C) * 2u; }
    const size_t kstep = (size_t)(BK * 2);
    const size_t hstep = (size_t)HALF * K * 2;
    const size_t tstep = 2 * hstep;
    const unsigned ldsw = (unsigned)wid * 1024u;
    const int aoff = lds_byte(wr * 64 + fr, fq * 8), boff = lds_byte(wc * 32 + fr, fq * 8);
#define PG8_SA(b, h) (((b) * 2 + (h)) * HTB)
#define PG8_SB(b, h) ((4 + (b) * 2 + (h)) * HTB)
#define PG8_STAGE(bufoff, gbase, voff) do { _Pragma("unroll") for (int _i = 0; _i < 2; ++_i) \
        __builtin_amdgcn_global_load_lds((const unsigned*)((const char*)(gbase) + (voff)[_i]), (PG8_LAS unsigned*)(lds + (bufoff) + ldsw + _i * 8192), 16, 0, 0); } while (0)
#define PG8_LDA(dst, b, h) do { _Pragma("unroll") for (int m = 0; m < 4; ++m) _Pragma("unroll") for (int k = 0; k < 2; ++k) dst[m][k] = *(const PG8_LAS bf16x8*)(lds + PG8_SA(b, h) + aoff + m * 2048 + k * 1024); } while (0)
#define PG8_LDB(dst, b, h) do { _Pragma("unroll") for (int n = 0; n < 2; ++n) _Pragma("unroll") for (int k = 0; k < 2; ++k) dst[n][k] = *(const PG8_LAS bf16x8*)(lds + PG8_SB(b, h) + boff + n * 2048 + k * 1024); } while (0)
#define PG8_MMA(ai, bj, At, Bt) do { __builtin_amdgcn_s_setprio(1); _Pragma("unroll") for (int m = 0; m < 4; ++m) _Pragma("unroll") for (int n = 0; n < 2; ++n) _Pragma("unroll") for (int k = 0; k < 2; ++k) \
        acc[ai][bj][m][n] = __builtin_amdgcn_mfma_f32_16x16x32_bf16(Bt[n][k], At[m][k], acc[ai][bj][m][n], 0, 0, 0); __builtin_amdgcn_s_setprio(0); } while (0)
#define PG8_WAIT_V(n) asm volatile("s_waitcnt vmcnt(" #n ")" ::: "memory")
#define PG8_WAIT_L(n) asm volatile("s_waitcnt lgkmcnt(" #n ")" ::: "memory")
#define PG8_BAR __builtin_amdgcn_s_barrier()
#define PG8_SCHED __builtin_amdgcn_sched_barrier(0)
    Unit cur, nxt; int ui = 0;
    if (!S.next(0, cur)) return;
    f32x4 acc[2][2][4][2];
#pragma unroll
    for (int a = 0; a < 2; ++a)
#pragma unroll
        for (int b = 0; b < 2; ++b)
#pragma unroll
            for (int m = 0; m < 4; ++m)
#pragma unroll
                for (int n = 0; n < 2; ++n) acc[a][b][m][n] = (f32x4){0.f, 0.f, 0.f, 0.f};
    bf16x8 At[4][2], B0[2][2], B1[2][2];
    const char* cA = (const char*)g.A + (size_t)cur.pm * tstep; const char* cB = (const char*)g.Bt + (size_t)cur.pn * tstep;
    S.a_ready(cur);
    if constexpr (SP2) {
        PG8_STAGE(PG8_SB(0, 0), cB, voffB); PG8_STAGE(PG8_SB(0, 1), cB + hstep, voffB); PG8_STAGE(PG8_SA(0, 0), cA, voffA); PG8_STAGE(PG8_SA(0, 1), cA + hstep, voffA);
        if (wr == 1) PG8_BAR;
        PG8_WAIT_V(2); PG8_BAR;
        PG8_STAGE(PG8_SB(1, 0), cB + kstep, voffB); PG8_STAGE(PG8_SA(1, 0), cA + kstep, voffA); PG8_STAGE(PG8_SB(1, 1), cB + hstep + kstep, voffB);
        PG8_WAIT_V(6); PG8_BAR;
    } else {
        PG8_STAGE(PG8_SB(0, 0), cB, voffB); PG8_STAGE(PG8_SA(0, 0), cA, voffA); PG8_STAGE(PG8_SB(0, 1), cB + hstep, voffB); PG8_STAGE(PG8_SA(0, 1), cA + hstep, voffA);
        if (wr == 1) PG8_BAR;
        PG8_WAIT_V(4); PG8_BAR;
        PG8_STAGE(PG8_SB(1, 0), cB + kstep, voffB); PG8_STAGE(PG8_SA(1, 0), cA + kstep, voffA); PG8_STAGE(PG8_SB(1, 1), cB + hstep + kstep, voffB);
        PG8_WAIT_V(6); PG8_BAR;
    }
    for (;;) {
        const bool has_next = S.next(ui + 1, nxt);
        const char* nA = has_next ? (const char*)g.A + (size_t)nxt.pm * tstep : cA; const char* nB = has_next ? (const char*)g.Bt + (size_t)nxt.pn * tstep : cB;
        for (int t = 0; t < nt; t += 2) {
            const bool last = (t == nt - 2);
            const char* a1 = cA + (size_t)(t + 1) * kstep;
            const char* a2 = last ? nA : cA + (size_t)(t + 2) * kstep; const char* b2 = last ? nB : cB + (size_t)(t + 2) * kstep;
            const char* a3 = a2 + kstep; const char* b3 = b2 + kstep;
            if (last && has_next) S.a_ready(nxt);
            if constexpr (SP2) {
            PG8_LDB(B0, 0, 0); PG8_LDB(B1, 0, 1); PG8_SCHED; PG8_LDA(At, 0, 0); PG8_STAGE(PG8_SA(1, 1), a1 + hstep, voffA);
            PG8_WAIT_V(8); PG8_WAIT_L(0); PG8_BAR; PG8_MMA(0, 0, At, B0); PG8_MMA(0, 1, At, B1); PG8_BAR; PG8_SCHED;
            PG8_LDA(At, 0, 1); PG8_STAGE(PG8_SB(0, 0), b2, voffB); PG8_STAGE(PG8_SB(0, 1), b2 + hstep, voffB); PG8_STAGE(PG8_SA(0, 0), a2, voffA);
            PG8_WAIT_V(8); PG8_WAIT_L(0); PG8_BAR; PG8_MMA(1, 0, At, B0); PG8_MMA(1, 1, At, B1); PG8_BAR; PG8_SCHED;
            PG8_LDB(B0, 1, 0); PG8_LDB(B1, 1, 1); PG8_SCHED; PG8_LDA(At, 1, 0); PG8_STAGE(PG8_SA(0, 1), a2 + hstep, voffA);
            PG8_WAIT_V(8); PG8_WAIT_L(0); PG8_BAR; PG8_MMA(0, 0, At, B0); PG8_MMA(0, 1, At, B1); PG8_BAR; PG8_SCHED;
            PG8_LDA(At, 1, 1); PG8_STAGE(PG8_SB(1, 0), b3, voffB); PG8_STAGE(PG8_SB(1, 1), b3 + hstep, voffB); PG8_STAGE(PG8_SA(1, 0), a3, voffA);
            PG8_WAIT_V(8); PG8_WAIT_L(0); PG8_BAR; PG8_MMA(1, 0, At, B0); PG8_MMA(1, 1, At, B1); PG8_BAR; PG8_SCHED;
            } else {
            PG8_LDB(B0, 0, 0); PG8_SCHED; PG8_LDA(At, 0, 0); PG8_STAGE(PG8_SA(1, 1), a1 + hstep, voffA);
            PG8_WAIT_L(8); PG8_BAR; PG8_WAIT_L(0); PG8_MMA(0, 0, At, B0); PG8_BAR; PG8_SCHED;
            PG8_LDB(B1, 0, 1); PG8_STAGE(PG8_SB(0, 0), b2, voffB);
            PG8_BAR; PG8_WAIT_L(0); PG8_MMA(0, 1, At, B1); PG8_BAR;
            PG8_LDA(At, 0, 1); PG8_STAGE(PG8_SA(0, 0), a2, voffA);
            PG8_BAR; PG8_WAIT_L(0); PG8_MMA(1, 0, At, B0); PG8_BAR; PG8_SCHED;
            PG8_STAGE(PG8_SB(0, 1), b2 + hstep, voffB);
            PG8_WAIT_V(6); PG8_BAR; PG8_MMA(1, 1, At, B1); PG8_BAR;
            PG8_LDB(B0, 1, 0); PG8_SCHED; PG8_LDA(At, 1, 0); PG8_STAGE(PG8_SA(0, 1), a2 + hstep, voffA);
            PG8_WAIT_L(8); PG8_BAR; PG8_WAIT_L(0); PG8_MMA(0, 0, At, B0); PG8_BAR; PG8_SCHED;
            PG8_LDB(B1, 1, 1); PG8_STAGE(PG8_SB(1, 0), b3, voffB);
            PG8_BAR; PG8_WAIT_L(0); PG8_MMA(0, 1, At, B1); PG8_BAR;
            PG8_LDA(At, 1, 1); PG8_STAGE(PG8_SA(1, 0), a3, voffA);
            PG8_BAR; PG8_WAIT_L(0); PG8_MMA(1, 0, At, B0); PG8_BAR; PG8_SCHED;
            PG8_STAGE(PG8_SB(1, 1), b3 + hstep, voffB);
            PG8_WAIT_V(6); PG8_BAR; PG8_MMA(1, 1, At, B1); PG8_BAR;
            }
        }
        if constexpr (ALIGN_EPI) { if (wr == 0) PG8_BAR; }
        if constexpr (!Epi::AFTER_DRAIN) { E(acc, cur, wr, wc, fr, fq); S.done(cur); }
        if (!has_next) break;
#pragma unroll
        for (int a = 0; a < 2; ++a)
#pragma unroll
            for (int b = 0; b < 2; ++b)
#pragma unroll
                for (int m = 0; m < 4; ++m)
#pragma unroll
                    for (int n = 0; n < 2; ++n) acc[a][b][m][n] = (f32x4){0.f, 0.f, 0.f, 0.f};
        cur = nxt; cA = nA; cB = nB; ++ui;
        if constexpr (ALIGN_EPI) { if (wr == 1) PG8_BAR; }
    }
    PG8_WAIT_V(0);
    if constexpr (!ALIGN_EPI) { if (wr == 0) PG8_BAR; }
    PG8_BAR;
    if constexpr (Epi::AFTER_DRAIN) { E.fused(acc, cur, wr, wc, fr, fq, lds, wid, lane); S.done(cur); }
#undef PG8_SA
#undef PG8_SB
#undef PG8_STAGE
#undef PG8_LDA
#undef PG8_LDB
#undef PG8_MMA
#undef PG8_WAIT_V
#undef PG8_WAIT_L
#undef PG8_BAR
#undef PG8_SCHED
}
}
#ifndef PG8_SP2
#define PG8_SP2 true
#endif
#ifndef PG8_ALIGN
#define PG8_ALIGN true
#endif
namespace att {
using bf16x8 = __attribute__((ext_vector_type(8))) short;
using s16x4 = __attribute__((ext_vector_type(4))) short;
using f32x16 = __attribute__((ext_vector_type(16))) float;
using u32x4 = __attribute__((ext_vector_type(4))) unsigned;
using f32x4 = __attribute__((ext_vector_type(4))) float;
typedef unsigned short bf16_t;
#define ALDS __attribute__((address_space(3)))
#define SBAR() __builtin_amdgcn_sched_barrier(0)
constexpr int SEQ = 8192, NBATCH = 4;
constexpr float LOG2E = 1.4426950408889634f;
__device__ __forceinline__ int crow(int r, int hi) { return (r & 3) + 8 * (r >> 2) + 4 * hi; }
typedef float f32x2_t __attribute__((ext_vector_type(2))); typedef __bf16 bf16x2_t __attribute__((ext_vector_type(2)));
__device__ __forceinline__ unsigned cvtpk_s(float lo, float hi) { f32x2_t v = {lo, hi}; bf16x2_t b = __builtin_convertvector(v, bf16x2_t); return __builtin_bit_cast(unsigned, b); }
__device__ __forceinline__ float bf_lo(unsigned w) { return __uint_as_float(w << 16); }
__device__ __forceinline__ float bf_hi(unsigned w) { return __uint_as_float(w & 0xffff0000u); }
#define MX3(a, b, c) __builtin_fmaxf(__builtin_fmaxf((a), (b)), (c))
__device__ __forceinline__ float rowmax(const f32x16& p0, const f32x16& p1) {
    float a = MX3(p0[0], p0[1], p1[0]), b = MX3(p0[2], p0[3], p1[1]); a = MX3(a, p1[2], p1[3]);
#pragma unroll
    for (int r = 4; r < 16; r += 4) { a = MX3(a, p0[r], p0[r + 1]); b = MX3(b, p0[r + 2], p0[r + 3]); a = MX3(a, p1[r], p1[r + 1]); b = MX3(b, p1[r + 2], p1[r + 3]); }
    float m = __builtin_fmaxf(a, b); auto rr = __builtin_amdgcn_permlane32_swap(__float_as_uint(m), __float_as_uint(m), false, false);
    return __builtin_fmaxf(__uint_as_float(rr[0]), __uint_as_float(rr[1])); }
template <int NDS> __device__ __forceinline__ void qkt(f32x16& p0, f32x16& p1, const ALDS char* Kslot, const bf16x8* qr, int r32, int hi) {
    const ALDS char* kb = Kslot + hi * 1024 + r32 * 16;
    p0 = f32x16{}; p1 = f32x16{};
#pragma unroll
    for (int d0 = 0; d0 < NDS; ++d0) {
        const bf16x8 b0 = *(const ALDS bf16x8*)(kb + d0 * 2048), b1 = *(const ALDS bf16x8*)(kb + d0 * 2048 + 512);
        p0 = __builtin_amdgcn_mfma_f32_32x32x16_bf16(b0, qr[d0], p0, 0, 0, 0); p1 = __builtin_amdgcn_mfma_f32_32x32x16_bf16(b1, qr[d0], p1, 0, 0, 0); }
}
__device__ __forceinline__ void pv(f32x16* o, int vb, bf16x8 pa0, bf16x8 pa1, bf16x8 pa2, bf16x8 pa3) {
#pragma unroll
    for (int d0 = 0; d0 < 2; ++d0) { s16x4 lo[4], hi[4];
#pragma unroll
        for (int ks = 0; ks < 4; ++ks) {
            asm volatile("ds_read_b64_tr_b16 %0,%1 offset:%c2" : "=&v"(lo[ks]) : "v"(vb), "i"(d0 * 4096 + ks * 1024) : "memory");
            asm volatile("ds_read_b64_tr_b16 %0,%1 offset:%c2" : "=&v"(hi[ks]) : "v"(vb), "i"(d0 * 4096 + ks * 1024 + 512) : "memory"); }
        asm volatile("s_waitcnt lgkmcnt(0)" ::: "memory"); SBAR();
#define PK(k) (bf16x8){lo[k][0], lo[k][1], lo[k][2], lo[k][3], hi[k][0], hi[k][1], hi[k][2], hi[k][3]}
        o[d0] = __builtin_amdgcn_mfma_f32_32x32x16_bf16(pa0, PK(0), o[d0], 0, 0, 0);
        o[d0] = __builtin_amdgcn_mfma_f32_32x32x16_bf16(pa1, PK(1), o[d0], 0, 0, 0);
        o[d0] = __builtin_amdgcn_mfma_f32_32x32x16_bf16(pa2, PK(2), o[d0], 0, 0, 0);
        o[d0] = __builtin_amdgcn_mfma_f32_32x32x16_bf16(pa3, PK(3), o[d0], 0, 0, 0);
#undef PK
    }
}
__device__ __forceinline__ void softmax_pv(f32x16& p0, f32x16& p1, float& m, float& l, f32x16* o, ALDS float* wsf, int vb, int r32, int hi) {
    const float rm = rowmax(p0, p1), mn = __builtin_fmaxf(m, rm), alpha = __builtin_amdgcn_exp2f(m - mn); m = mn;
    float ls = 0.f;
#pragma unroll
    for (int r = 0; r < 16; ++r) { p0[r] = __builtin_amdgcn_exp2f(p0[r] - mn); p1[r] = __builtin_amdgcn_exp2f(p1[r] - mn); ls += p0[r] + p1[r]; }
    l = l * alpha + ls;
    if (hi == 0) wsf[r32] = alpha;
    asm volatile("s_waitcnt lgkmcnt(0)" ::: "memory");
#pragma unroll
    for (int d = 0; d < 2; ++d)
#pragma unroll
        for (int r = 0; r < 16; ++r) o[d][r] *= wsf[crow(r, hi)];
    u32x4 pw0 = {cvtpk_s(p0[0], p0[1]), cvtpk_s(p0[2], p0[3]), cvtpk_s(p0[4], p0[5]), cvtpk_s(p0[6], p0[7])};
    u32x4 pw1 = {cvtpk_s(p0[8], p0[9]), cvtpk_s(p0[10], p0[11]), cvtpk_s(p0[12], p0[13]), cvtpk_s(p0[14], p0[15])};
    u32x4 pw2 = {cvtpk_s(p1[0], p1[1]), cvtpk_s(p1[2], p1[3]), cvtpk_s(p1[4], p1[5]), cvtpk_s(p1[6], p1[7])};
    u32x4 pw3 = {cvtpk_s(p1[8], p1[9]), cvtpk_s(p1[10], p1[11]), cvtpk_s(p1[12], p1[13]), cvtpk_s(p1[14], p1[15])};
    asm volatile("s_waitcnt lgkmcnt(0)" ::: "memory"); SBAR();
    pv(o, vb, __builtin_bit_cast(bf16x8, pw0), __builtin_bit_cast(bf16x8, pw1), __builtin_bit_cast(bf16x8, pw2), __builtin_bit_cast(bf16x8, pw3));
}
__device__ __forceinline__ void attn_epilogue(const f32x16* o, float l, ALDS float* wsf, ALDS bf16_t* stg, const bf16_t* G, bf16_t* Y, size_t grow, int ycol, int lane, int r32, int hi) {
    { auto rr = __builtin_amdgcn_permlane32_swap(__float_as_uint(l), __float_as_uint(l), false, false); l = __uint_as_float(rr[0]) + __uint_as_float(rr[1]); }
    if (hi == 0) wsf[32 + r32] = l;
    asm volatile("s_waitcnt lgkmcnt(0)" ::: "memory");
    float rli[16];
#pragma unroll
    for (int r = 0; r < 16; ++r) rli[r] = __builtin_amdgcn_rcpf(wsf[32 + crow(r, hi)]);
#pragma unroll
    for (int r = 0; r < 16; ++r) { const int orow = crow(r, hi);
#pragma unroll
        for (int d0 = 0; d0 < 2; ++d0) { const float v = o[d0][r] * rli[r]; stg[orow * 64 + d0 * 32 + r32] = (bf16_t)(cvtpk_s(v, v) & 0xffffu); } }
    asm volatile("s_waitcnt lgkmcnt(0)" ::: "memory");
#pragma unroll
    for (int i = 0; i < 4; ++i) { const int row = i * 8 + (lane >> 3), ch = lane & 7;
        const u32x4 v = *(const ALDS u32x4*)(stg + row * 64 + ch * 8);
        const size_t off = (grow + row) * 1024 + ycol + ch * 8;
        const u32x4 g = *(const u32x4*)(G + off); u32x4 y;
#pragma unroll
        for (int k = 0; k < 4; ++k) y[k] = cvtpk_s(bf_lo(v[k]) * bf_lo(g[k]), bf_hi(v[k]) * bf_hi(g[k]));
        *(u32x4*)(Y + off) = y; }
    asm volatile("s_waitcnt lgkmcnt(0)" ::: "memory");
}

struct AttnPtrs { const bf16_t *QN, *QPE, *KN, *KPE, *V, *QS, *KS, *VS, *G; bf16_t* Y; const int* pos; const float *sinks, *relb, *COS, *SIN; };
constexpr int A_KV = 0;
constexpr int A_MLA_SLOT = 20480, A_MLA_V = 12288;
constexpr int A_SWA_V = 32768;
constexpr int A_WSF = 65536;
constexpr int A_OST = A_WSF + 8 * 256;
constexpr int A_KPOS = A_OST + 8 * 4096;
constexpr int A_TAB = A_KPOS + 1024;
constexpr int A_END = A_TAB + 4 * 132 * 4;

__device__ __forceinline__ void mla_unit(int b, int h, int qb, const AttnPtrs& P, ALDS char* shm) {
    const int tid = threadIdx.x, lane = tid & 63, r32 = lane & 31, hi = lane >> 5; const int wid = __builtin_amdgcn_readfirstlane(tid >> 6);
    const size_t rowbase = (size_t)b * SEQ; const int q0 = qb * 256, NT = (q0 + 256) / 64;
    const size_t qrow = rowbase + q0 + wid * 32 + r32;
    bf16x8 qr[6];
#pragma unroll
    for (int d0 = 0; d0 < 4; ++d0) qr[d0] = *(const bf16x8*)(P.QN + qrow * 512 + h * 64 + d0 * 16 + hi * 8);
#pragma unroll
    for (int d0 = 0; d0 < 2; ++d0) {
        const u32x4 w = *(const u32x4*)(P.QPE + qrow * 256 + h * 32 + d0 * 16 + hi * 8);
        const f32x4 c = *(const f32x4*)(P.COS + qrow * 16 + 4 * (2 * d0 + hi)), s = *(const f32x4*)(P.SIN + qrow * 16 + 4 * (2 * d0 + hi));
        const f32x4 x1 = {bf_lo(w[0]), bf_hi(w[0]), bf_lo(w[1]), bf_hi(w[1])}, x2 = {bf_lo(w[2]), bf_hi(w[2]), bf_lo(w[3]), bf_hi(w[3])};
        const f32x4 o1 = x1 * c - x2 * s, o2 = x2 * c + x1 * s;
        const u32x4 r = {cvtpk_s(o1[0], o1[1]), cvtpk_s(o1[2], o1[3]), cvtpk_s(o2[0], o2[1]), cvtpk_s(o2[2], o2[3])};
        qr[4 + d0] = __builtin_bit_cast(bf16x8, r); }
    const bf16_t* ksrc = P.KN + (rowbase + lane) * 512 + h * 64 + wid * 8;
    const bf16_t* kpsrc = P.KPE + (rowbase + lane) * 32 + (wid & 3) * 8;
    const bf16_t* vsrc = P.V + (rowbase + 16 * (wid & 3) + (lane >> 2)) * 512 + h * 64 + (wid >> 2) * 32 + (lane & 3) * 8;
    const int kdst = wid * 1024 + lane * 16, kpdst = (8 + (wid & 3)) * 1024 + lane * 16, vdst = A_MLA_V + wid * 1024 + lane * 16;
    ALDS float* wsf = (ALDS float*)(shm + A_WSF) + wid * 64;
    ALDS bf16_t* stg = (ALDS bf16_t*)(shm + A_OST) + wid * 2048;
    const int vb0 = (int)(unsigned)(uintptr_t)(shm + A_KV + A_MLA_V) + ((lane >> 4) & 1) * 32 + (lane & 3) * 8 + (4 * hi + ((lane & 15) >> 2)) * 64;
    float m = -1e30f, l = 0.f; f32x16 o[2]; o[0] = f32x16{}; o[1] = f32x16{};
    const int qrel = wid * 32 + r32;
    u32x4 kreg, kpreg = {0, 0, 0, 0}, vreg;
    kreg = *(const u32x4*)(ksrc); if (wid < 4) kpreg = *(const u32x4*)(kpsrc); vreg = *(const u32x4*)(vsrc);
    *(ALDS u32x4*)(shm + A_KV + kdst) = kreg; if (wid < 4) *(ALDS u32x4*)(shm + A_KV + kpdst) = kpreg; *(ALDS u32x4*)(shm + A_KV + vdst) = vreg;
    __syncthreads();
    for (int t = 0; t < NT; ++t) {
        const int boff = A_KV + (t & 1) * A_MLA_SLOT, noff = A_KV + ((t + 1) & 1) * A_MLA_SLOT;
        if (t + 1 < NT) { kreg = *(const u32x4*)(ksrc + (size_t)(t + 1) * 64 * 512); if (wid < 4) kpreg = *(const u32x4*)(kpsrc + (size_t)(t + 1) * 64 * 32); vreg = *(const u32x4*)(vsrc + (size_t)(t + 1) * 64 * 512); }
        f32x16 p0, p1;
        qkt<6>(p0, p1, shm + boff, qr, r32, hi);
        const int jb = t - (NT - 4);
        if (jb >= 0) { const int kb = 64 * jb + 4 * hi;
#pragma unroll
            for (int r = 0; r < 16; ++r) { const int kv = kb + (r & 3) + 8 * (r >> 2); if (kv > qrel) p0[r] = -INFINITY; if (kv + 32 > qrel) p1[r] = -INFINITY; } }
        softmax_pv(p0, p1, m, l, o, wsf, vb0 + (t & 1) * A_MLA_SLOT, r32, hi);
        if (t + 1 < NT) { *(ALDS u32x4*)(shm + noff + kdst) = kreg; if (wid < 4) *(ALDS u32x4*)(shm + noff + kpdst) = kpreg; *(ALDS u32x4*)(shm + noff + vdst) = vreg; }
        __syncthreads();
    }
    attn_epilogue(o, l, wsf, stg, P.G, P.Y, rowbase + q0 + wid * 32, h * 64, lane, r32, hi);
}

__device__ __forceinline__ int t5_bucket(int n) {
    if (n < 16) return n;
    const int large = 16 + (int)(__logf((float)n * (1.0f / 16.0f)) / 2.0794415416798357f * 16.0f);
    return large < 31 ? large : 31;
}
__device__ __forceinline__ void swa_unit(int b, int kvh, int blk, const AttnPtrs& P, ALDS char* shm) {
    const int tid = threadIdx.x, lane = tid & 63, r32 = lane & 31, hi = lane >> 5; const int wid = __builtin_amdgcn_readfirstlane(tid >> 6);
    const size_t rowbase = (size_t)b * SEQ; const int kb0 = blk * 128 - 128;
    ALDS int* kposL = (ALDS int*)(shm + A_KPOS); ALDS float* tab = (ALDS float*)(shm + A_TAB);
    const int t_first = (blk == 0) ? 2 : 0;
    for (int tt = t_first; tt < 4; ++tt) {
        const size_t krow = rowbase + kb0 + tt * 64;
        const u32x4 kreg = *(const u32x4*)(P.KS + (krow + lane) * 128 + kvh * 64 + wid * 8);
        const u32x4 vreg = *(const u32x4*)(P.VS + (krow + 16 * (wid & 3) + (lane >> 2)) * 128 + kvh * 64 + (wid >> 2) * 32 + (lane & 3) * 8);
        *(ALDS u32x4*)(shm + A_KV + tt * 8192 + wid * 1024 + lane * 16) = kreg;
        *(ALDS u32x4*)(shm + A_SWA_V + tt * 8192 + wid * 1024 + lane * 16) = vreg;
    }
    if (tid < 256) kposL[tid] = (kb0 + tid >= 0) ? P.pos[rowbase + kb0 + tid] : 0;
    for (int i = tid; i < 4 * 129; i += 512) { const int g = i / 129, n = i - g * 129; tab[g * 132 + n] = P.relb[t5_bucket(n) * 8 + kvh * 4 + g] * LOG2E; }
    __syncthreads();
    ALDS float* wsf = (ALDS float*)(shm + A_WSF) + wid * 64;
    ALDS bf16_t* stg = (ALDS bf16_t*)(shm + A_OST) + wid * 2048;
    const int g = wid & 3, hq = kvh * 4 + g;
    const int vb0 = (int)(unsigned)(uintptr_t)(shm + A_SWA_V) + ((lane >> 4) & 1) * 32 + (lane & 3) * 8 + (4 * hi + ((lane & 15) >> 2)) * 64;
    const float sink2 = P.sinks[hq] * LOG2E;
    for (int jj = 0; jj < 2; ++jj) {
        const int j = (wid >> 2) * 2 + jj;
        const size_t qrow = rowbase + blk * 128 + j * 32 + r32;
        bf16x8 qr[4];
#pragma unroll
        for (int d0 = 0; d0 < 4; ++d0) qr[d0] = *(const bf16x8*)(P.QS + qrow * 512 + hq * 64 + d0 * 16 + hi * 8);
        const int qpos = P.pos[qrow], qband = 128 + j * 32 + r32;
        float m = sink2, l = (hi == 0) ? 1.0f : 0.0f; f32x16 o[2]; o[0] = f32x16{}; o[1] = f32x16{};
        const int tlo = (wid >> 2);
        for (int tt = tlo; tt < tlo + 3; ++tt) {
            if (tt < t_first) continue;
            f32x16 p0, p1;
            qkt<4>(p0, p1, shm + A_KV + tt * 8192, qr, r32, hi);
#pragma unroll
            for (int r = 0; r < 16; ++r) {
#pragma unroll
                for (int hf = 0; hf < 2; ++hf) {
                    const int kk = tt * 64 + crow(r, hi) + 32 * hf, delta = qband - kk;
                    int n = qpos - kposL[kk]; n = n < 0 ? 0 : (n > 128 ? 128 : n);
                    const float bias = tab[g * 132 + n];
                    const float s = (hf ? p1[r] : p0[r]) + bias;
                    const float v = (delta >= 0 && delta < 128) ? s : -INFINITY;
                    if (hf) p1[r] = v; else p0[r] = v; } }
            softmax_pv(p0, p1, m, l, o, wsf, vb0 + tt * 8192, r32, hi);
        }
        attn_epilogue(o, l, wsf, stg, P.G, P.Y, rowbase + blk * 128 + j * 32, 512 + hq * 64, lane, r32, hi);
    }
    __syncthreads();
}
}
namespace att {
#define PIN(x) asm volatile("" : "+v"(x))
#define MFMA(a, b, c) __builtin_amdgcn_mfma_f32_32x32x16_bf16(a, b, c, 0, 0, 0)
#define WAIT_BAR(N) asm volatile("s_waitcnt vmcnt(" #N ") lgkmcnt(0)\n\ts_barrier" ::: "memory")
#define WAIT2(A, B) do { if (wid < 4) { WAIT_BAR(A); } else { WAIT_BAR(B); } } while (0)
__device__ __forceinline__ void glds16(const void* g, unsigned lds_base) {
    unsigned sv; asm volatile("s_mov_b32 %0, m0\n\ts_mov_b32 m0, %2\n\ts_nop 0\n\tglobal_load_lds_dwordx4 %1, off\n\ts_mov_b32 m0, %0" : "=&s"(sv) : "v"(g), "s"(lds_base) : "memory"); }
typedef ALDS const char* lds_cptr;
typedef short v4i16_t __attribute__((ext_vector_type(4)));
__device__ __forceinline__ void kload2(bf16x8* kf, lds_cptr kp, int d0) { kf[2 * d0] = *(const ALDS bf16x8*)(kp + d0 * 2048); kf[2 * d0 + 1] = *(const ALDS bf16x8*)(kp + d0 * 2048 + 512); }
__device__ __forceinline__ s16x4 vtr(lds_cptr p) { return __builtin_bit_cast(s16x4, __builtin_amdgcn_ds_read_tr16_b64_v4i16((ALDS v4i16_t*)p)); }
__device__ __forceinline__ void cmask(f32x16& p0, f32x16& p1, int dq) {
#pragma unroll
    for (int r = 0; r < 16; ++r) { const int c = (r & 3) + 8 * (r >> 2); if (c > dq) p0[r] = -INFINITY; if (c + 32 > dq) p1[r] = -INFINITY; } }

constexpr int PK_SLOT = 12288, PV_SLOT = 8192;
constexpr int PL_K = 0, PL_V = 4 * PK_SLOT, PL_WS = PL_V + 3 * PV_SLOT, PL_OST = PL_WS + 8 * 256, PL_END = PL_OST + 8 * 4096;

template <int THRL> __device__ __forceinline__ void mla_unit_pipe(int b, int h, int qb, const AttnPtrs& P, ALDS char* shm) {
    const int tid = threadIdx.x, lane = tid & 63, r32 = lane & 31, hi = lane >> 5; const int wid = __builtin_amdgcn_readfirstlane(tid >> 6);
    const size_t rowbase = (size_t)b * SEQ; const int q0 = qb * 256, NT = (q0 + 256) / 64;
    const size_t qrow = rowbase + q0 + wid * 32 + r32;
    const unsigned lds0 = (unsigned)(uintptr_t)shm; ALDS float* wsf = (ALDS float*)(shm + PL_WS) + wid * 64;
    const bf16_t* ksrc = P.KN + (rowbase + lane) * 512 + h * 64 + wid * 8;
    const bf16_t* kpsrc = P.KPE + (rowbase + lane) * 32 + (wid & 3) * 8;
    const bf16_t* vsrc = P.V + (rowbase + 16 * (wid & 3) + (lane >> 2)) * 512 + h * 64 + (wid >> 2) * 32 + (lane & 3) * 8;
    const unsigned kdst = lds0 + PL_K + wid * 1024, kpdst = lds0 + PL_K + (8 + (wid & 3)) * 1024, vdst = lds0 + PL_V + wid * 1024;
#define DMA_K(t, slot) do { glds16(ksrc + (size_t)(t) * 64 * 512, (unsigned)__builtin_amdgcn_readfirstlane(kdst + (slot))); \
        if (wid < 4) glds16(kpsrc + (size_t)(t) * 64 * 32, (unsigned)__builtin_amdgcn_readfirstlane(kpdst + (slot))); } while (0)
#define DMA_V(t, slot) glds16(vsrc + (size_t)(t) * 64 * 512, (unsigned)__builtin_amdgcn_readfirstlane(vdst + (slot)))
    const lds_cptr vp0 = (lds_cptr)shm + PL_V + ((lane >> 4) & 1) * 32 + (lane & 3) * 8 + (4 * hi + ((lane & 15) >> 2)) * 64;
    const lds_cptr kp0 = (lds_cptr)shm + PL_K + hi * 1024 + r32 * 16;
    DMA_K(0, 0); DMA_V(0, 0); DMA_K(1, PK_SLOT);
    bf16x8 qr[6];
#pragma unroll
    for (int d0 = 0; d0 < 4; ++d0) qr[d0] = *(const bf16x8*)(P.QN + qrow * 512 + h * 64 + d0 * 16 + hi * 8);
#pragma unroll
    for (int d0 = 0; d0 < 2; ++d0) {
        const u32x4 w = *(const u32x4*)(P.QPE + qrow * 256 + h * 32 + d0 * 16 + hi * 8);
        const f32x4 c = *(const f32x4*)(P.COS + qrow * 16 + 4 * (2 * d0 + hi)), s = *(const f32x4*)(P.SIN + qrow * 16 + 4 * (2 * d0 + hi));
        const f32x4 x1 = {bf_lo(w[0]), bf_hi(w[0]), bf_lo(w[1]), bf_hi(w[1])}, x2 = {bf_lo(w[2]), bf_hi(w[2]), bf_lo(w[3]), bf_hi(w[3])};
        const f32x4 o1 = x1 * c - x2 * s, o2 = x2 * c + x1 * s;
        const u32x4 r = {cvtpk_s(o1[0], o1[1]), cvtpk_s(o1[2], o1[3]), cvtpk_s(o2[0], o2[1]), cvtpk_s(o2[2], o2[3])};
        qr[4 + d0] = __builtin_bit_cast(bf16x8, r); }
    float mhat = 0.f, l_reg = 0.f; f32x16 o[2]; o[0] = f32x16{}; o[1] = f32x16{}; f32x16 negm = f32x16{}; PIN(negm);
    const int qrel = wid * 32 + r32; bool resc = false;
    f32x16 pA0, pA1, pB0, pB1; bf16x8 kf[12]; s16x4 vlo[8], vhi[8]; u32x4 pw0, pw1, pw2, pw3;
    int sk_prev = 3 * PK_SLOT, sk_cur = 0, sk_next = PK_SLOT, sv_prev = 0, sv_cur = 0, sv_next = PV_SLOT;
#define ROT() do { sk_prev = sk_cur; sk_cur = sk_next; sk_next = (sk_next == 3 * PK_SLOT) ? 0 : sk_next + PK_SLOT; sv_prev = sv_cur; sv_cur = sv_next; sv_next = (sv_next == 2 * PV_SLOT) ? 0 : sv_next + PV_SLOT; } while (0)
#define EX(v) __builtin_amdgcn_exp2f(v)
#define RESC() do { if (resc) { _Pragma("unroll") for (int d_ = 0; d_ < 2; ++d_) _Pragma("unroll") for (int r = 0; r < 16; ++r) o[d_][r] *= wsf[crow(r, hi)]; } } while (0)
#define KR(i, base) kf[i] = *(const ALDS bf16x8*)((base) + ((i) >> 1) * 2048 + ((i) & 1) * 512)
    DMA_K(2, 2 * PK_SLOT);
    WAIT2(5, 3);
    _Pragma("unroll") for (int i = 0; i < 12; ++i) KR(i, kp0);
    pA0 = MFMA(kf[0], qr[0], negm); pA1 = MFMA(kf[1], qr[0], negm);
    _Pragma("unroll") for (int d0 = 1; d0 < 6; ++d0) { pA0 = MFMA(kf[2 * d0], qr[d0], pA0); pA1 = MFMA(kf[2 * d0 + 1], qr[d0], pA1); }
    if (NT == 4) cmask(pA0, pA1, qrel - 4 * hi);
    { const float rm = rowmax(pA0, pA1); mhat = rm;
#pragma unroll
      for (int r = 0; r < 16; ++r) { pA0[r] = EX(pA0[r] - rm); pA1[r] = EX(pA1[r] - rm); }
#pragma unroll
      for (int r = 0; r < 16; ++r) negm[r] = -mhat;
      PIN(negm); }
    DMA_K(3, sk_prev); DMA_V(1, PV_SLOT);
    WAIT2(5, 3);
    ROT();
    KR(0, kp0 + sk_cur); KR(1, kp0 + sk_cur); KR(2, kp0 + sk_cur); KR(3, kp0 + sk_cur);
#define PKW(Pv, i) cvtpk_s(Pv[i], Pv[(i) + 1])
#define PAF(k) __builtin_bit_cast(bf16x8, pw##k)
#define VFR(i) (bf16x8){vlo[i][0], vlo[i][1], vlo[i][2], vlo[i][3], vhi[i][0], vhi[i][1], vhi[i][2], vhi[i][3]}
#define VRD(i) do { vlo[i] = vtr(vp_ + (((i) >> 2) * 4096 + ((i) & 3) * 1024)); vhi[i] = vtr(vp_ + (((i) >> 2) * 4096 + ((i) & 3) * 1024 + 512)); } while (0)
#define GAP(PRE, MF, FILL) do { PRE; SBAR(); MF; FILL; SBAR(); } while (0)
#define GAPB(PRE, MF, X, i) do { PRE; SBAR(); MF; X[i] = EX(X[i]); X[(i) + 1] = EX(X[(i) + 1]); X[(i) + 2] = EX(X[(i) + 2]); X[(i) + 3] = EX(X[(i) + 3]); PIN(X); SBAR(); } while (0)
#define STEP(C0, C1, P0, P1, t, MASK, GK, GV, GL) do { SBAR(); \
    const lds_cptr vp_ = vp0 + sv_prev; const lds_cptr kc_ = kp0 + sk_cur; const lds_cptr kn_ = kp0 + sk_next; \
    float sacc = P0[0] + P0[1]; \
    GAP(KR(4, kc_),  C0 = MFMA(kf[0], qr[0], negm), sacc += P0[2]; sacc += P0[3]; sacc += P0[4]; pw0[0] = PKW(P0, 0); PIN(pw0); PIN(sacc)); \
    GAP(KR(5, kc_),  C1 = MFMA(kf[1], qr[0], negm), sacc += P0[5]; sacc += P0[6]; sacc += P0[7]; pw0[1] = PKW(P0, 2); PIN(pw0); PIN(sacc)); \
    GAP(KR(6, kc_),  C0 = MFMA(kf[2], qr[1], C0),  sacc += P0[8]; sacc += P0[9]; sacc += P0[10]; pw0[2] = PKW(P0, 4); pw0[3] = PKW(P0, 6); PIN(pw0); PIN(sacc)); \
    GAP(KR(7, kc_),  C1 = MFMA(kf[3], qr[1], C1),  sacc += P0[11]; sacc += P0[12]; pw1[0] = PKW(P0, 8); pw1[1] = PKW(P0, 10); PIN(pw1); PIN(sacc)); \
    GAP(KR(8, kc_),  C0 = MFMA(kf[4], qr[2], C0),  sacc += P0[13]; sacc += P0[14]; sacc += P0[15]; pw1[2] = PKW(P0, 12); PIN(pw1); PIN(sacc)); \
    GAP(KR(9, kc_),  C1 = MFMA(kf[5], qr[2], C1),  sacc += P1[0]; sacc += P1[1]; sacc += P1[2]; pw1[3] = PKW(P0, 14); PIN(pw1); PIN(sacc)); \
    GAP(KR(10, kc_), C0 = MFMA(kf[6], qr[3], C0),  sacc += P1[3]; sacc += P1[4]; sacc += P1[5]; pw2[0] = PKW(P1, 0); PIN(pw2); PIN(sacc)); \
    GAP(KR(11, kc_), C1 = MFMA(kf[7], qr[3], C1),  sacc += P1[6]; sacc += P1[7]; pw2[1] = PKW(P1, 2); pw2[2] = PKW(P1, 4); PIN(pw2); PIN(sacc)); \
    GAP((void)0,     C0 = MFMA(kf[8], qr[4], C0),  sacc += P1[8]; sacc += P1[9]; sacc += P1[10]; pw2[3] = PKW(P1, 6); PIN(pw2); PIN(sacc)); \
    GAP((void)0,     C1 = MFMA(kf[9], qr[4], C1),  sacc += P1[11]; sacc += P1[12]; pw3[0] = PKW(P1, 8); pw3[1] = PKW(P1, 10); PIN(pw3); PIN(sacc)); \
    GAP(VRD(0),      C0 = MFMA(kf[10], qr[5], C0), sacc += P1[13]; sacc += P1[14]; sacc += P1[15]; pw3[2] = PKW(P1, 12); PIN(pw3); PIN(sacc)); \
    GAP(VRD(4),      C1 = MFMA(kf[11], qr[5], C1), pw3[3] = PKW(P1, 14); PIN(pw3)); \
    l_reg += sacc; \
    if (GK) DMA_K((t) + 3, sk_prev); if (GV) DMA_V((t) + 1, sv_next); \
    if (MASK) cmask(C0, C1, qrel - 4 * hi - 64 * ((t) - (NT - 4))); \
    { const float rm = rowmax(C0, C1); resc = false; \
      if (__builtin_expect(__any(rm > (float)THRL), 0)) { const float dl = __builtin_fmaxf(rm, 0.f); mhat += dl; \
          _Pragma("unroll") for (int r = 0; r < 16; ++r) { C0[r] -= dl; C1[r] -= dl; } \
          _Pragma("unroll") for (int r = 0; r < 16; ++r) negm[r] = -mhat; PIN(negm); \
          const float f = __builtin_amdgcn_exp2f(-dl); l_reg *= f; if (hi == 0) wsf[r32] = f; resc = true; } } \
    SBAR(); \
    GAPB(VRD(1), o[0] = MFMA(PAF(0), VFR(0), o[0]), C0, 0); \
    GAPB(VRD(5), o[1] = MFMA(PAF(0), VFR(4), o[1]), C0, 4); \
    GAPB(VRD(2), o[0] = MFMA(PAF(1), VFR(1), o[0]), C0, 8); \
    GAPB(VRD(6), o[1] = MFMA(PAF(1), VFR(5), o[1]), C0, 12); \
    GAPB(VRD(3), o[0] = MFMA(PAF(2), VFR(2), o[0]), C1, 0); \
    GAPB(VRD(7), o[1] = MFMA(PAF(2), VFR(6), o[1]), C1, 4); \
    GAPB(if (GL) { KR(0, kn_); KR(1, kn_); }, o[0] = MFMA(PAF(3), VFR(3), o[0]), C1, 8); \
    GAPB(if (GL) { KR(2, kn_); KR(3, kn_); }, o[1] = MFMA(PAF(3), VFR(7), o[1]), C1, 12); \
    } while (0)
    int t = 1;
    for (; t + 5 < NT; t += 2) {
        STEP(pB0, pB1, pA0, pA1, t, false, true, true, true);     WAIT2(3, 2); RESC(); ROT();
        STEP(pA0, pA1, pB0, pB1, t + 1, false, true, true, true); WAIT2(3, 2); RESC(); ROT();
    }
#define ENDW(tt) do { if ((tt) + 3 < NT) { WAIT2(3, 2); } else if ((tt) + 2 < NT) { WAIT_BAR(1); } else { WAIT_BAR(0); } } while (0)
    for (; t + 1 < NT; t += 2) {
        STEP(pB0, pB1, pA0, pA1, t, true, (t + 3 < NT), (t + 1 < NT), (t + 1 < NT));         ENDW(t);     RESC(); ROT();
        STEP(pA0, pA1, pB0, pB1, t + 1, true, (t + 4 < NT), (t + 2 < NT), (t + 2 < NT));     ENDW(t + 1); RESC(); ROT();
    }
    STEP(pB0, pB1, pA0, pA1, NT - 1, true, false, false, false); RESC();
    { float sacc = pB0[0] + pB0[1];
#pragma unroll
      for (int r = 2; r < 16; ++r) sacc += pB0[r];
#pragma unroll
      for (int r = 0; r < 16; ++r) sacc += pB1[r];
      l_reg += sacc;
      pw0 = (u32x4){PKW(pB0, 0), PKW(pB0, 2), PKW(pB0, 4), PKW(pB0, 6)}; pw1 = (u32x4){PKW(pB0, 8), PKW(pB0, 10), PKW(pB0, 12), PKW(pB0, 14)};
      pw2 = (u32x4){PKW(pB1, 0), PKW(pB1, 2), PKW(pB1, 4), PKW(pB1, 6)}; pw3 = (u32x4){PKW(pB1, 8), PKW(pB1, 10), PKW(pB1, 12), PKW(pB1, 14)};
      const lds_cptr vp_ = vp0 + sv_cur; _Pragma("unroll") for (int i = 0; i < 8; ++i) VRD(i);
      o[0] = MFMA(PAF(0), VFR(0), o[0]); o[1] = MFMA(PAF(0), VFR(4), o[1]); o[0] = MFMA(PAF(1), VFR(1), o[0]); o[1] = MFMA(PAF(1), VFR(5), o[1]);
      o[0] = MFMA(PAF(2), VFR(2), o[0]); o[1] = MFMA(PAF(2), VFR(6), o[1]); o[0] = MFMA(PAF(3), VFR(3), o[0]); o[1] = MFMA(PAF(3), VFR(7), o[1]); }
    attn_epilogue(o, l_reg, wsf, (ALDS bf16_t*)(shm + PL_OST) + wid * 2048, P.G, P.Y, rowbase + q0 + wid * 32, h * 64, lane, r32, hi);
    asm volatile("s_waitcnt lgkmcnt(0)\n\ts_barrier" ::: "memory");
#undef DMA_K
#undef DMA_V
#undef ROT
#undef EX
#undef RESC
#undef KR
#undef PKW
#undef PAF
#undef VFR
#undef VRD
#undef GAP
#undef GAPB
#undef STEP
#undef ENDW
}
}
#define GAS __attribute__((address_space(1)))
#define LAS __attribute__((address_space(3)))
typedef unsigned short bf16;
typedef unsigned v4u __attribute__((ext_vector_type(4)));
typedef float f32x4 __attribute__((ext_vector_type(4)));
typedef short bf16x8 __attribute__((ext_vector_type(8)));
typedef GAS unsigned gu32;
typedef GAS unsigned long long gu64;
#define RLX_AGENT __ATOMIC_RELAXED, __HIP_MEMORY_SCOPE_AGENT
#define LDS_WAIT() asm volatile("s_waitcnt lgkmcnt(0)" ::: "memory")
#define VM_WAIT() asm volatile("s_waitcnt vmcnt(0)" ::: "memory")
__device__ __forceinline__ unsigned long long rt() { return __builtin_amdgcn_s_memrealtime(); }
__device__ __forceinline__ unsigned f2bf(float f) { unsigned u = __builtin_bit_cast(unsigned, f); return (u + 0x7fffu + ((u >> 16) & 1u)) >> 16; }
__device__ __forceinline__ unsigned pk2(float lo, float hi) { return f2bf(lo) | (f2bf(hi) << 16); }

#define XB_TMO      128
#define XB_XCNT(j)  (256  + 64 * (j))
#define XB_XSUB(j)  (1280 + 64 * (j))
#define XB_XGEN(j)  (2304 + 64 * (j))
#define XB_TOP      3328
#define XB_TOPGEN   3392
#define XCD_BAR_WORDS 3456
#define XB_SPIN_CAP (1u << 18)

__device__ __forceinline__ unsigned xb_ld(unsigned* p)              { return __hip_atomic_load(p, __ATOMIC_RELAXED, __HIP_MEMORY_SCOPE_AGENT); }
__device__ __forceinline__ unsigned xb_add(unsigned* p, unsigned v) { return __hip_atomic_fetch_add(p, v, __ATOMIC_RELAXED, __HIP_MEMORY_SCOPE_AGENT); }
__device__ __forceinline__ unsigned xb_xcc_id() { return (unsigned)__builtin_amdgcn_s_getreg((3 << 11) | 20) & 0xFu; }
#define XB_SPIN(cond, bar) do { unsigned _sp = 0; while (cond) { __builtin_amdgcn_s_sleep(1); \
    if ((++_sp & 255u) == 0u) { if (xb_ld(&(bar)[XB_TMO])) break; if (_sp > XB_SPIN_CAP) { atomicAdd(&(bar)[XB_TMO], 1u); break; } } } } while (0)

struct XcdBarrier {
    unsigned* bar; unsigned x;
    volatile LAS unsigned* st;
};

__device__ __forceinline__ XcdBarrier xcd_barrier_post(unsigned* bar, volatile LAS unsigned* st) {
    XcdBarrier b; b.bar = bar; b.x = xb_xcc_id(); b.st = st;
    if (threadIdx.x == 0) (void)xb_add(&bar[XB_XCNT(b.x)], 1u);
    return b;
}
__device__ __forceinline__ void xcd_barrier_complete(unsigned* bar, unsigned x, unsigned& nloc, unsigned& nx) {
    const unsigned G = gridDim.x * gridDim.y * gridDim.z;
    unsigned sum, cnt, mine, sp = 0u;
    for (;;) {
        sum = 0u; cnt = 0u; mine = 0u;
#pragma unroll
        for (unsigned j = 0; j < 16; ++j) { const unsigned c = xb_ld(&bar[XB_XCNT(j)]); sum += c; cnt += (c > 0u) ? 1u : 0u; mine = (j == x) ? c : mine; }
        if (sum == G) break;
        __builtin_amdgcn_s_sleep(1);
        if ((++sp & 255u) == 0u) { if (xb_ld(&bar[XB_TMO])) break; if (sp > XB_SPIN_CAP) { atomicAdd(&bar[XB_TMO], 1u); break; } }
    }
    nloc = mine > 0u ? mine : 1u; nx = cnt > 0u ? cnt : 1u;
}

__device__ __forceinline__ void xcd_barrier(const XcdBarrier& b) {
    asm volatile("s_waitcnt vmcnt(0)" ::: "memory");
    __syncthreads();
    if (threadIdx.x == 0) {
        unsigned* bar = b.bar;
        __builtin_amdgcn_s_waitcnt(0);
        unsigned nloc = b.st[0], nx = b.st[1];
        if (nloc == 0u) { xcd_barrier_complete(bar, b.x, nloc, nx); b.st[0] = nloc; b.st[1] = nx; }
        const unsigned old = xb_add(&bar[XB_XSUB(b.x)], 1u);
        const unsigned gen = old / nloc;
        if (old + 1u == (gen + 1u) * nloc) {
            __builtin_amdgcn_fence(__ATOMIC_RELEASE, "agent");
            asm volatile("s_waitcnt vmcnt(0)" ::: "memory");
            const unsigned og = xb_add(&bar[XB_TOP], 1u);
            const unsigned tg = og / nx;
            if (og + 1u == (tg + 1u) * nx) xb_add(&bar[XB_TOPGEN], 1u);
            else XB_SPIN(xb_ld(&bar[XB_TOPGEN]) == tg, bar);
            __builtin_amdgcn_fence(__ATOMIC_ACQUIRE, "agent");
            xb_add(&bar[XB_XGEN(b.x)], 1u);
            asm volatile("s_waitcnt vmcnt(0)" ::: "memory");
        } else {
            XB_SPIN(xb_ld(&bar[XB_XGEN(b.x)]) == gen, bar);
            __builtin_amdgcn_fence(__ATOMIC_ACQUIRE, "agent");
            asm volatile("s_waitcnt vmcnt(0)" ::: "memory");
        }
    }
    __syncthreads();
}
constexpr int NWAVES = 8;
#ifndef MK_N_LAUNCHES
#define MK_N_LAUNCHES 1
#endif
constexpr int N_LAUNCHES = MK_N_LAUNCHES;
constexpr int PER_PHASE = 6;
constexpr int BATCH = 4, T = 8192, D = 1024, M = BATCH * T;
constexpr int IN_W = 2208, NP1 = 2304;
constexpr float EPS = 1e-6f;
constexpr float C2_MLA = 0.14724444602590306f;
constexpr float C2_SWA = 0.18033688011112042f;

constexpr size_t MiB = 1u << 20;
constexpr size_t WS_CTL = 0, CTL_ZERO_BYTES = 1 * MiB;
constexpr size_t WS_WQ = 1 * MiB, WS_WKV = 1 * MiB + 512 * 1024, WS_WIN = 2 * MiB, WS_WOUT = 7 * MiB;
constexpr size_t WS_COS = 9 * MiB, WS_SIN = 11 * MiB, WS_PQ = 13 * MiB, WS_PKV = 13 * MiB + 512 * 1024;
constexpr size_t WS_QL = 16 * MiB, WS_KVL = 32 * MiB, WS_KS = 40 * MiB, WS_VS = 48 * MiB, WS_KPE = 56 * MiB;
constexpr size_t WS_QS = 64 * MiB, WS_G = 96 * MiB, WS_XN = 160 * MiB;
constexpr size_t WS_QN = 224 * MiB, WS_QPE = 256 * MiB, WS_KN = 272 * MiB, WS_V = 304 * MiB, WS_Y = 336 * MiB, WS_END = 400 * MiB;
constexpr int CW_TMO = 0, CW_CODE = 1, CW_BAR = 4096;

constexpr int RING_OFF = 0, RING_BYTES = 131072;
constexpr int LDSCTL_OFF = RING_BYTES, MISC_OFF = LDSCTL_OFF + 320;
constexpr int LDS_BYTES = 147456;
static_assert(att::A_END <= RING_BYTES && att::PL_END <= RING_BYTES, "attention scratch inside the ring region");

__device__ __forceinline__ float wave_sum(float v) {
#pragma unroll
    for (int o = 1; o < 64; o <<= 1) v += __shfl_xor(v, o);
    return v;
}
__device__ __forceinline__ void p0_transpose_item(const float* W, int N, int k0, int n0, const float* gain, bf16* WT, int K, int drow0, bool perm, LAS float* scr, int lane) {
#pragma unroll 8
    for (int i = 0; i < 32; ++i) { const int kk = 2 * i + (lane >> 5); const float g = gain ? gain[k0 + kk] : 1.0f; scr[kk * 33 + (lane & 31)] = W[(size_t)(k0 + kk) * N + n0 + (lane & 31)] * g; }
    LDS_WAIT(); asm volatile("" ::: "memory");
    const int c = lane & 7;
#pragma unroll
    for (int j = 0; j < 4; ++j) { const int n = (lane >> 3) + 8 * j; const LAS float* s = scr + (8 * c) * 33 + n;
        v4u o; o.x = pk2(s[0 * 33], s[1 * 33]); o.y = pk2(s[2 * 33], s[3 * 33]); o.z = pk2(s[4 * 33], s[5 * 33]); o.w = pk2(s[6 * 33], s[7 * 33]);
        const int dn = perm ? (8 * ((n & 15) >> 2) + 4 * (n >> 4) + (n & 3)) : n;
        *(GAS v4u*)(WT + (size_t)(drow0 + dn) * K + k0 + 8 * c) = o; }
    LDS_WAIT(); asm volatile("" ::: "memory");
}
__device__ __forceinline__ int win_dest_row(int n0) {
    if (n0 < 384) return n0;
    if (n0 < 416) return 640;
    if (n0 < 928) return 768 + (n0 - 416);
    if (n0 < 1056) return 384 + (n0 - 928);
    if (n0 < 1184) return 512 + (n0 - 1056);
    return 1280 + (n0 - 1184);
}
__constant__ float ROPE_INV[16] = {1.0f, 0.5623413251903491f, 0.31622776601683794f, 0.1778279410038923f, 0.1f, 0.05623413251903491f, 0.03162277660168379f, 0.01778279410038923f,
    0.01f, 0.005623413251903491f, 0.0031622776601683794f, 0.0017782794100389228f, 0.001f, 0.0005623413251903491f, 0.00031622776601683794f, 0.00017782794100389227f};

struct Args { const float* in[12]; const int* pos; float* out; unsigned char* ws; int ph_lo, ph_hi, li, pad; };

__global__ void __launch_bounds__(NWAVES * 64, 2) fwd_kernel(Args args) {
    extern __shared__ __attribute__((aligned(16))) unsigned char lds[];
    LAS unsigned char* L = (LAS unsigned char*)lds;
    volatile LAS unsigned* MISC = (volatile LAS unsigned*)(L + MISC_OFF);
    const int tid = threadIdx.x, lane = tid & 63, wave = __builtin_amdgcn_readfirstlane(tid >> 6);
    const int G = gridDim.x, bx = blockIdx.x, vcu = (G % 8 == 0) ? (bx % 8) * (G / 8) + bx / 8 : bx;
    unsigned char* ws = args.ws;
    gu32* ctl = (gu32*)(ws + WS_CTL);
    const float* x = args.in[0];
    bf16* Wq_t = (bf16*)(ws + WS_WQ); bf16* Wkv_t = (bf16*)(ws + WS_WKV); bf16* Win_t = (bf16*)(ws + WS_WIN); bf16* Wout_t = (bf16*)(ws + WS_WOUT);
    float* COS = (float*)(ws + WS_COS); float* SIN = (float*)(ws + WS_SIN); float* PQ = (float*)(ws + WS_PQ); float* PKV = (float*)(ws + WS_PKV);
    bf16 *QL = (bf16*)(ws + WS_QL), *KVL = (bf16*)(ws + WS_KVL), *KS = (bf16*)(ws + WS_KS), *VS = (bf16*)(ws + WS_VS), *KPE = (bf16*)(ws + WS_KPE);
    bf16 *QS = (bf16*)(ws + WS_QS), *GT = (bf16*)(ws + WS_G), *XN = (bf16*)(ws + WS_XN);
    bf16 *QN = (bf16*)(ws + WS_QN), *QPE = (bf16*)(ws + WS_QPE), *KN = (bf16*)(ws + WS_KN), *VV = (bf16*)(ws + WS_V), *Y = (bf16*)(ws + WS_Y);

    for (int u = tid; u < (LDS_BYTES - LDSCTL_OFF) / 4; u += NWAVES * 64) ((LAS unsigned*)(L + LDSCTL_OFF))[u] = 0u;
    __syncthreads();
    XcdBarrier bar; bar.bar = (unsigned*)(ctl + CW_BAR); bar.x = 0; bar.st = nullptr;
    if (N_LAUNCHES != PER_PHASE) bar = xcd_barrier_post((unsigned*)(ctl + CW_BAR), MISC + 8);
#define GRID_BAR(seam) do { if (N_LAUNCHES == PER_PHASE) { if (tid == 0) __hip_atomic_store(ctl + CW_TMO, 0xBADBA0u | (unsigned)(seam), RLX_AGENT); } else { xcd_barrier(bar); } } while (0)
    const int lo = args.ph_lo, hi = args.ph_hi;
#ifndef PH_MASK
#define PH_MASK 63
#endif
#define IN(k) (((PH_MASK >> (k)) & 1) && lo <= (k) && (k) < hi)
#define BOTH(k) (IN(k) && IN((k) + 1))

    if (IN(0)) {
        LAS float* scr = (LAS float*)(L + RING_OFF + wave * 16384);
        const int gw = vcu * NWAVES + wave, NGW = G * NWAVES;
        constexpr int I_IN = 16 * 69, I_Q = 4 * 24, I_KV = 2 * 32, I_OUT = 16 * 32, NITEMS = I_IN + I_Q + I_KV + I_OUT;
        for (int it = gw; it < NITEMS; it += NGW) {
            int r = it;
            if (r < I_IN) { const int kb = r / 69, cb = r % 69, n0 = 32 * cb; p0_transpose_item(args.in[3], IN_W, 64 * kb, n0, args.in[2], Win_t, 1024, win_dest_row(n0), cb == 12, scr, lane); continue; } r -= I_IN;
            if (r < I_Q) { const int kb = r / 24, cb = r % 24, h = cb / 3, part = cb % 3; p0_transpose_item(args.in[5], 768, 64 * kb, 32 * cb, args.in[4], Wq_t, 256, part < 2 ? h * 64 + part * 32 : 512 + h * 32, part == 2, scr, lane); continue; } r -= I_Q;
            if (r < I_KV) { const int kb = r / 32, cb = r % 32, h = cb / 4, part = cb % 4; p0_transpose_item(args.in[7], 1024, 64 * kb, 32 * cb, args.in[6], Wkv_t, 128, part < 2 ? h * 64 + part * 32 : 512 + h * 64 + (part - 2) * 32, false, scr, lane); continue; } r -= I_KV;
            { const int kb = r / 32, cb = r % 32; p0_transpose_item(args.in[10], 1024, 64 * kb, 32 * cb, nullptr, Wout_t, 1024, 32 * cb, false, scr, lane); }
        }
        { const int gt = vcu * (NWAVES * 64) + tid, NGT = G * NWAVES * 64; for (int i = gt; i < 96 * 1024 / 8; i += NGT) ((GAS v4u*)(Win_t + 672 * 1024))[i] = (v4u){0u, 0u, 0u, 0u};
          for (int e = gt; e < M * 16; e += NGT) { const int m = e >> 4, i = e & 15; const float a = (float)args.pos[m] * ROPE_INV[i];
              const double rev = (double)a * 0.15915494309189535; const float fr = (float)(rev - __builtin_rint(rev));
              COS[e] = __builtin_amdgcn_cosf(fr); SIN[e] = __builtin_amdgcn_sinf(fr); } }
        for (int m = gw; m < M; m += NGW) {
            const GAS f32x4* xr = (const GAS f32x4*)(x + (size_t)m * D) + lane; f32x4 v[4]; float s = 0.f;
#pragma unroll
            for (int j = 0; j < 4; ++j) { v[j] = xr[64 * j]; s += (v[j].x * v[j].x + v[j].y * v[j].y) + (v[j].z * v[j].z + v[j].w * v[j].w); }
            const float rstd = 1.0f / sqrtf(wave_sum(s) * (1.0f / D) + EPS);
            GAS unsigned long long* o8 = (GAS unsigned long long*)(XN + (size_t)m * D) + lane;
#pragma unroll
            for (int j = 0; j < 4; ++j) o8[64 * j] = (unsigned long long)pk2(v[j].x * rstd, v[j].y * rstd) | ((unsigned long long)pk2(v[j].z * rstd, v[j].w * rstd) << 32);
        }
        if (BOTH(0)) GRID_BAR(0);
    }
    if (IN(1)) {
        pg8::Gemm g{XN, Win_t, M, NP1, D}; pg8::StaticOrder S; S.init(M, NP1, G, bx);
        pg8::EpiProj E{QL, KVL, KS, VS, KPE, QS, GT, PQ, PKV, COS, SIN, C2_SWA};
        pg8::gemm_phase<pg8::EpiProj, pg8::StaticOrder, PG8_ALIGN, PG8_SP2>(L + RING_OFF, g, S, E);
        if (BOTH(1)) GRID_BAR(1);
    }
    if (IN(2)) {
#pragma clang loop unroll(disable)
        for (int gi = 0; gi < 2; ++gi) {
            const pg8::Gemm g = (gi == 0) ? pg8::Gemm{QL, Wq_t, M, 768, 256} : pg8::Gemm{KVL, Wkv_t, M, 1024, 128};
            const pg8::EpiRS E = (gi == 0) ? pg8::EpiRS{QN, QPE, 256, PQ, 1.0f / 256.0f, C2_MLA, EPS} : pg8::EpiRS{KN, VV, 512, PKV, 1.0f / 128.0f, 1.0f, EPS};
            pg8::StaticOrder S; S.init(M, g.N, G, bx);
            pg8::gemm_phase<pg8::EpiRS, pg8::StaticOrder, PG8_ALIGN, PG8_SP2>(L + RING_OFF, g, S, E);
        }
        if (BOTH(2)) GRID_BAR(2);
    }
    if (IN(3)) {
        att::AttnPtrs P{QN, QPE, KN, KPE, VV, QS, KS, VS, GT, Y, args.pos, args.in[8], args.in[9], COS, SIN};
        ALDS char* shm = (ALDS char*)(L + RING_OFF);
        {
            const bool deal = (G == 256); const int n_mine = deal ? 4 : (1024 - bx + G - 1) / G;
            for (int i = 0; i < n_mine; ++i) {
                int bh, qb;
                if (deal) { const int s = vcu & 7; bh = vcu >> 3; qb = (i == 0) ? s : (i == 1) ? 15 - s : (i == 2) ? 16 + s : 31 - s; }
                else { const int u = bx + i * G; bh = u >> 5; qb = u & 31; }
                att::mla_unit_pipe<8>(bh >> 3, bh & 7, qb, P, shm);
            }
        }
        for (int u = bx; u < 512; u += G) att::swa_unit(u >> 7, (u >> 6) & 1, u & 63, P, shm);
        if (BOTH(3)) GRID_BAR(3);
    }
    if (IN(4)) {
        pg8::Gemm g{Y, Wout_t, M, D, D}; pg8::StaticOrder S; S.init(M, D, G, bx);
        pg8::EpiOut E{x, args.out};
        pg8::gemm_phase<pg8::EpiOut, pg8::StaticOrder, PG8_ALIGN, PG8_SP2>(L + RING_OFF, g, S, E);
        if (BOTH(4)) GRID_BAR(4);
    }
    if (IN(5)) {
        const int gw = vcu * NWAVES + wave, NGW = G * NWAVES; const float* fn = args.in[11];
        f32x4 gv[4];
#pragma unroll
        for (int j = 0; j < 4; ++j) gv[j] = ((const GAS f32x4*)fn)[lane + 64 * j];
        for (int m = gw; m < M; m += NGW) {
            GAS f32x4* xr = (GAS f32x4*)(args.out + (size_t)m * D) + lane; f32x4 v[4]; float s = 0.f;
#pragma unroll
            for (int j = 0; j < 4; ++j) { v[j] = xr[64 * j]; s += (v[j].x * v[j].x + v[j].y * v[j].y) + (v[j].z * v[j].z + v[j].w * v[j].w); }
            const float rstd = 1.0f / sqrtf(wave_sum(s) * (1.0f / D) + EPS);
#pragma unroll
            for (int j = 0; j < 4; ++j) xr[64 * j] = v[j] * rstd * gv[j];
        }
    }
#undef IN
#undef BOTH
}

extern "C" void kernel_launch(void* const* d_in, const int* in_sizes, int n_in, void* d_out, int out_size, void* d_ws, size_t ws_size, hipStream_t stream) {
    static int grid = 0;
    if (grid == 0) {
        if (n_in != 12 || in_sizes[0] != M * D || out_size != M * D || ws_size < WS_END) { fprintf(stderr, "kernel_launch: unexpected shapes (n_in %d, in0 %d, out %d, ws %zu)\n", n_in, n_in > 0 ? in_sizes[0] : -1, out_size, ws_size); grid = -1; return; }
        int dev = 0, cus = 0;
        if (hipGetDevice(&dev) != hipSuccess || hipDeviceGetAttribute(&cus, hipDeviceAttributeMultiprocessorCount, dev) != hipSuccess) { grid = -1; return; }
        if (hipFuncSetAttribute((const void*)fwd_kernel, hipFuncAttributeMaxDynamicSharedMemorySize, LDS_BYTES) != hipSuccess) { fprintf(stderr, "kernel_launch: hipFuncSetAttribute failed\n"); grid = -1; return; }
        int per_cu = 0;
        if (hipOccupancyMaxActiveBlocksPerMultiprocessor(&per_cu, (const void*)fwd_kernel, NWAVES * 64, LDS_BYTES) != hipSuccess || per_cu < 1) fprintf(stderr, "kernel_launch: occupancy query says %d\n", per_cu);
        (void)hipGetLastError();
        grid = cus;
    }
    if (grid < 0) return;
    (void)hipMemsetAsync((char*)d_ws + WS_CTL, 0, CTL_ZERO_BYTES, stream);
    Args a{};
    for (int i = 0; i < 12; ++i) a.in[i] = (const float*)d_in[i];
    a.pos = (const int*)d_in[1]; a.out = (float*)d_out; a.ws = (unsigned char*)d_ws;
    if (N_LAUNCHES == 1) { a.ph_lo = 0; a.ph_hi = PER_PHASE; a.li = 0; hipLaunchKernelGGL(fwd_kernel, dim3(grid), dim3(NWAVES * 64), LDS_BYTES, stream, a); }
    else for (int li = 0; li < PER_PHASE; ++li) { a.ph_lo = li; a.ph_hi = li + 1; a.li = li; hipLaunchKernelGGL(fwd_kernel, dim3(grid), dim3(NWAVES * 64), LDS_BYTES, stream, a); }
}
```
